# Optimizing an MI355X kernel written in HIP

```python
import jax, jax.numpy as jnp
from jax import lax
import numpy as np

D_MODEL = 1024
BATCH = 1
SEQ = 16384
DEPTH = 2

CONV_WIDTH = 512
CONV_K = 3
POOL_WINDOWS = (2, 4, 8, 16)
POOL_WIDTH = 512
POOL_GROUP = POOL_WIDTH // len(POOL_WINDOWS)
EVEN_SIZES = (CONV_WIDTH, CONV_WIDTH, CONV_WIDTH, CONV_WIDTH, POOL_WIDTH, POOL_WIDTH)
EVEN_IN = sum(EVEN_SIZES)
EVEN_OUT = CONV_WIDTH + POOL_WIDTH

ATT_HEADS = 8
ATT_KV_HEADS = 2
ATT_HEAD_DIM = 64
ATT_WIDTH = ATT_HEADS * ATT_HEAD_DIM
ATT_KV_WIDTH = ATT_KV_HEADS * ATT_HEAD_DIM
WINDOW = 128
BLOCK = 128
MLSTM_HEADS = 4
MLSTM_QK_DIM = 64
MLSTM_V_DIM = 128
MLSTM_QK_WIDTH = MLSTM_HEADS * MLSTM_QK_DIM
MLSTM_WIDTH = MLSTM_HEADS * MLSTM_V_DIM
CHUNK = 64
ODD_SIZES = (ATT_WIDTH, ATT_KV_WIDTH, ATT_KV_WIDTH, ATT_WIDTH,
             MLSTM_QK_WIDTH, MLSTM_QK_WIDTH, MLSTM_WIDTH, MLSTM_HEADS, MLSTM_HEADS,
             MLSTM_WIDTH, MLSTM_WIDTH)
ODD_IN = sum(ODD_SIZES)
ODD_OUT = ATT_WIDTH + MLSTM_WIDTH

N_EVEN = (DEPTH + 1) // 2
N_ODD = DEPTH // 2
RMS_EPS = 1e-6

kernel_name = "hybrid_conv_pool_swa_mlstm_trunk"


def rmsnorm(x, g):
    xf = x.astype(jnp.float32)
    y = xf * lax.rsqrt(jnp.mean(xf * xf, axis=-1, keepdims=True) + RMS_EPS)
    return (y * g.astype(jnp.float32)).astype(x.dtype)


def split_cols(p, sizes):
    idx = np.cumsum(sizes)[:-1].tolist()
    return jnp.split(p, idx, axis=-1)


def alibi_slopes(n):
    return jnp.asarray([2.0 ** (-8.0 * (h + 1) / n) for h in range(n)], dtype=jnp.float32)


def short_conv_mixer(xa, bg, cg, conv_w):
    u = cg * xa
    y = lax.conv_general_dilated(
        u, conv_w[:, None, :].astype(u.dtype), window_strides=(1,),
        padding=[(CONV_K - 1, 0)], dimension_numbers=('NWC', 'WIO', 'NWC'),
        feature_group_count=u.shape[-1])
    return bg * y


def pool_mixer(u, pool_w, pool_scale):
    S = u.shape[1]
    t1 = jnp.arange(1, S + 1, dtype=jnp.float32)[None, :, None]
    outs = []
    for ug, w in zip(jnp.split(u, len(POOL_WINDOWS), axis=-1), POOL_WINDOWS):
        uf = ug.astype(jnp.float32)
        cs = jnp.cumsum(uf, axis=1)
        cs_lag = jnp.pad(cs, ((0, 0), (w, 0), (0, 0)))[:, :S]
        outs.append(((cs - cs_lag) / jnp.minimum(t1, float(w)) - uf).astype(u.dtype))
    d = jnp.stack(outs, axis=2)
    y = jnp.einsum('bsgc,gcd->bsgd', d, pool_w).reshape(u.shape)
    return y * pool_scale


def sliding_window_attention(q, k, v, sinks):
    B, S = q.shape[0], q.shape[1]
    NB = S // BLOCK
    R = ATT_HEADS // ATT_KV_HEADS
    qb = q.reshape(B, NB, BLOCK, ATT_KV_HEADS, R, ATT_HEAD_DIM)

    def with_prev(t):
        tb = t.reshape(B, NB, BLOCK, ATT_KV_HEADS, ATT_HEAD_DIM)
        prev = jnp.pad(tb, ((0, 0), (1, 0), (0, 0), (0, 0), (0, 0)))[:, :NB]
        return jnp.concatenate([prev, tb], axis=2)

    kk, vv = with_prev(k), with_prev(v)
    s = jnp.einsum('bnqgrd,bnkgd->bngrqk', qb, kk).astype(jnp.float32) * (ATT_HEAD_DIM ** -0.5)
    qi = jnp.arange(BLOCK)[:, None]
    kj = jnp.arange(2 * BLOCK)[None, :]
    dist = qi + BLOCK - kj
    in_window = (dist >= 0) & (dist < WINDOW)
    key_valid = (jnp.arange(NB)[:, None, None] > 0) | (kj >= BLOCK)[None]
    mask = in_window[None] & key_valid
    slopes = alibi_slopes(ATT_HEADS).reshape(ATT_KV_HEADS, R)
    s = s - slopes[:, :, None, None] * dist.astype(jnp.float32)
    s = jnp.where(mask[None, :, None, None], s, -jnp.inf)
    sink = jnp.broadcast_to(sinks.astype(jnp.float32).reshape(ATT_KV_HEADS, R)[:, :, None, None],
                            s.shape[:-1] + (1,))
    p = jax.nn.softmax(jnp.concatenate([s, sink], axis=-1), axis=-1)[..., :-1]
    o = jnp.einsum('bngrqk,bnkgd->bnqgrd', p.astype(vv.dtype), vv)
    return o.reshape(B, S, ATT_WIDTH)


def mlstm(q, k, v, i_pre, f_pre):
    B, S = q.shape[0], q.shape[1]
    H, L = MLSTM_HEADS, CHUNK
    NC = S // L
    f32 = jnp.float32

    def chunk(t):
        t = t.astype(f32).reshape((B, NC, L) + t.shape[2:])
        return jnp.moveaxis(t, 3, 1)

    qc = chunk(q) * (MLSTM_QK_DIM ** -0.5)
    kc, vc, ic = chunk(k), chunk(v), chunk(i_pre)
    b = jnp.cumsum(jax.nn.log_sigmoid(chunk(f_pre)), axis=-1)
    bL = b[..., -1]
    a = bL[..., None] - b + ic
    m_chunk = jnp.max(a, axis=-1)
    w = jnp.exp(a - m_chunk[..., None])
    Kc = jnp.einsum('bhcl,bhcld,bhcle->bhcde', w, kc, vc)
    Nc = jnp.einsum('bhcl,bhcld->bhcd', w, kc)

    def step(carry, inp):
        C, n, m = carry
        bL_c, m_c, K_c, N_c = inp
        m_new = jnp.maximum(bL_c + m, m_c)
        decay = jnp.exp(bL_c + m - m_new)
        sc = jnp.exp(m_c - m_new)
        C_new = decay[..., None, None] * C + sc[..., None, None] * K_c
        n_new = decay[..., None] * n + sc[..., None] * N_c
        return (C_new, n_new, m_new), (C, n, m)

    init = (jnp.zeros((B, H, MLSTM_QK_DIM, MLSTM_V_DIM), f32),
            jnp.zeros((B, H, MLSTM_QK_DIM), f32),
            jnp.zeros((B, H), f32))
    xs = (jnp.moveaxis(bL, 2, 0), jnp.moveaxis(m_chunk, 2, 0),
          jnp.moveaxis(Kc, 2, 0), jnp.moveaxis(Nc, 2, 0))
    _, (Cp, Np, Mp) = lax.scan(step, init, xs)
    Cp, Np, Mp = jnp.moveaxis(Cp, 0, 2), jnp.moveaxis(Np, 0, 2), jnp.moveaxis(Mp, 0, 2)

    g = b + Mp[..., None]
    Dm = b[..., :, None] - b[..., None, :] + ic[..., None, :]
    Dm = jnp.where(jnp.tril(jnp.ones((L, L), bool)), Dm, -jnp.inf)
    m_t = jnp.maximum(g, jnp.max(Dm, axis=-1))
    inter = jnp.exp(g - m_t)
    qk = jnp.einsum('bhcld,bhcsd->bhcls', qc, kc) * jnp.exp(Dm - m_t[..., None])
    num = inter[..., None] * jnp.einsum('bhcld,bhcde->bhcle', qc, Cp) + jnp.einsum('bhcls,bhcse->bhcle', qk, vc)
    den = inter * jnp.einsum('bhcld,bhcd->bhcl', qc, Np) + jnp.sum(qk, axis=-1)
    h = num / jnp.maximum(jnp.abs(den), jnp.exp(-m_t))[..., None]
    h = jnp.moveaxis(h, 1, 3).reshape(B, S, MLSTM_WIDTH)
    return h


def even_layer(x, norm_g, w_in, conv_w, pool_w, pool_scale, w_out):
    h = rmsnorm(x, norm_g)
    xa, bg, cg, gate_a, u, gate_b = split_cols(h @ w_in, EVEN_SIZES)
    ya = short_conv_mixer(xa, bg, cg, conv_w) * jax.nn.silu(gate_a)
    yb = pool_mixer(u, pool_w, pool_scale) * jax.nn.silu(gate_b)
    return x + jnp.concatenate([ya, yb], axis=-1) @ w_out


def odd_layer(x, norm_g, w_in, i_bias, f_bias, sinks, w_out):
    B, S = x.shape[0], x.shape[1]
    h = rmsnorm(x, norm_g)
    (cq, ck, cv, gate_c, dq, dk, dv, di, df, do, gate_d) = split_cols(h @ w_in, ODD_SIZES)
    att = sliding_window_attention(
        cq.reshape(B, S, ATT_HEADS, ATT_HEAD_DIM),
        ck.reshape(B, S, ATT_KV_HEADS, ATT_HEAD_DIM),
        cv.reshape(B, S, ATT_KV_HEADS, ATT_HEAD_DIM), sinks)
    yc = att * jax.nn.silu(gate_c)
    mem = mlstm(dq.reshape(B, S, MLSTM_HEADS, MLSTM_QK_DIM),
                dk.reshape(B, S, MLSTM_HEADS, MLSTM_QK_DIM),
                dv.reshape(B, S, MLSTM_HEADS, MLSTM_V_DIM),
                di.astype(jnp.float32) + i_bias.astype(jnp.float32),
                df.astype(jnp.float32) + f_bias.astype(jnp.float32))
    yd = (mem * jax.nn.sigmoid(do.astype(jnp.float32))).astype(x.dtype) * jax.nn.silu(gate_d)
    return x + jnp.concatenate([yc, yd], axis=-1) @ w_out


def setup_inputs(seed: int = 0) -> dict:
    key = jax.random.key(seed)
    ks = jax.random.split(key, 16)
    nrm = jax.random.normal
    D = D_MODEL
    return {
        "x": nrm(ks[0], (BATCH, SEQ, D), jnp.float32),
        "even_norm": 1.0 + 0.02 * nrm(ks[1], (N_EVEN, D), jnp.float32),
        "even_w_in": nrm(ks[2], (N_EVEN, D, EVEN_IN), jnp.float32) * D ** -0.5,
        "even_conv_w": nrm(ks[3], (N_EVEN, CONV_K, CONV_WIDTH), jnp.float32) * CONV_K ** -0.5,
        "even_pool_w": nrm(ks[4], (N_EVEN, len(POOL_WINDOWS), POOL_GROUP, POOL_GROUP), jnp.float32) * POOL_GROUP ** -0.5,
        "even_pool_scale": 1.0 + 0.02 * nrm(ks[5], (N_EVEN, POOL_WIDTH), jnp.float32),
        "even_w_out": nrm(ks[6], (N_EVEN, EVEN_OUT, D), jnp.float32) * EVEN_OUT ** -0.5,
        "odd_norm": 1.0 + 0.02 * nrm(ks[7], (N_ODD, D), jnp.float32),
        "odd_w_in": nrm(ks[8], (N_ODD, D, ODD_IN), jnp.float32) * D ** -0.5,
        "odd_i_bias": 0.1 * nrm(ks[9], (N_ODD, MLSTM_HEADS), jnp.float32),
        "odd_f_bias": 3.0 + 0.1 * nrm(ks[10], (N_ODD, MLSTM_HEADS), jnp.float32),
        "odd_sinks": 0.1 * nrm(ks[11], (N_ODD, ATT_HEADS), jnp.float32),
        "odd_w_out": nrm(ks[12], (N_ODD, ODD_OUT, D), jnp.float32) * ODD_OUT ** -0.5,
        "final_norm": 1.0 + 0.02 * nrm(ks[13], (D,), jnp.float32),
    }


def reference(x, even_norm, even_w_in, even_conv_w, even_pool_w, even_pool_scale, even_w_out,
              odd_norm, odd_w_in, odd_i_bias, odd_f_bias, odd_sinks, odd_w_out, final_norm):
    for layer in range(DEPTH):
        j = layer // 2
        if layer % 2 == 0:
            x = even_layer(x, even_norm[j], even_w_in[j], even_conv_w[j], even_pool_w[j],
                           even_pool_scale[j], even_w_out[j])
        else:
            x = odd_layer(x, odd_norm[j], odd_w_in[j], odd_i_bias[j], odd_f_bias[j],
                          odd_sinks[j], odd_w_out[j])
    return rmsnorm(x, final_norm)
```

```cpp
#include <hip/hip_runtime.h>
#include <cstdio>
#include <cstdint>

typedef unsigned short bf16;
constexpr int S = 16384, D = 1024;
constexpr int EVEN_IN = 3072, ODD_IN = 3336, ODD_PAD = 3584;
constexpr float RMS_EPS = 1e-6f;
constexpr int O_Q = 0, O_K = 512, O_V = 640, O_GC = 768, O_DQ = 1280, O_DK = 1536, O_DV = 1792, O_DO = 2304, O_GD = 2816, O_DI = 3328, O_DF = 3332;
constexpr int SC = 256, NSC = S / SC;

constexpr size_t MiB = 1u << 20;
constexpr size_t WS_CTL = 0;
constexpr size_t CTL_BYTES = 1 * MiB;
constexpr size_t WS_SS0 = 1 * MiB;
constexpr size_t WS_MSC = 1 * MiB + 128 * 1024;
constexpr size_t WS_W1 = 2 * MiB, WS_W2 = 8 * MiB, WS_W3 = 10 * MiB, WS_W4 = 17 * MiB;
constexpr size_t WS_XB = 20 * MiB, WS_YB = 52 * MiB, WS_PB = 84 * MiB, WS_CLOC = 196 * MiB, WS_END = 206 * MiB;
constexpr int CLOC_STRIDE = 64 * 128 + 64;

namespace pg8 {
#define PG8_LAS __attribute__((address_space(3)))
typedef unsigned short bf16_t;
typedef short bf16x8 __attribute__((ext_vector_type(8)));
typedef float f32x4 __attribute__((ext_vector_type(4)));
typedef unsigned u32x4 __attribute__((ext_vector_type(4)));
constexpr int BM = 256, BK = 64, HALF = 128, HTB = HALF * BK * 2  , STAGE_BYTES = 8 * HTB, NXCD = 8, WGM = 8;

__host__ __device__ __forceinline__ int lds_byte(int r, int c) { const int st = (r >> 4) * 2 + (c >> 5), rr = r & 15, cc = c & 31, ob = rr * 64 + cc * 2; return st * 1024 + (ob ^ (((ob >> 9) & 1) << 5)); }
__host__ __device__ __forceinline__ void stage_rc(int b, int& R, int& C) { const int st = b / 1024, sb = b % 1024, swz = sb ^ (((sb >> 9) & 1) << 5); R = (st >> 1) * 16 + swz / 64; C = (st & 1) * 32 + (swz % 64) / 2; }
__host__ __device__ __forceinline__ int perm32(int rho) { const int n = rho >> 4, i = rho & 15; return 8 * (i >> 2) + 4 * n + (i & 3); }

struct Unit { int pm, pn; };
struct Gemm { const bf16_t* A; const bf16_t* Bt; int M, N, K; };

struct StaticOrder {
    int nM, nN, nwg, G, c;
    __host__ __device__ void init(int M, int N, int G_, int c_) { nM = M / BM; nN = N / BM; nwg = nM * nN; G = G_; c = c_; }
    __host__ __device__ bool next(int i, Unit& u) const {
        const long L = (long)i * G + c; if (L >= nwg) return false;
        int wgid = (int)L; { const int q = nwg / NXCD, r = nwg % NXCD, xcd = wgid % NXCD, off = wgid / NXCD; wgid = (xcd < r ? xcd * (q + 1) : r * (q + 1) + (xcd - r) * q) + off; }
        const int nig = WGM * nN, gid = wgid / nig, fm = gid * WGM, gsz = (nM - fm) < WGM ? (nM - fm) : WGM;
        u.pm = fm + ((wgid % nig) % gsz); u.pn = (wgid % nig) / gsz; return true;
    }
    __device__ __forceinline__ void a_ready(const Unit&) const {}
    __device__ __forceinline__ void done(const Unit&) const {}
};

typedef float f32x2_t __attribute__((ext_vector_type(2))); typedef __bf16 bf16x2_t __attribute__((ext_vector_type(2)));
__device__ __forceinline__ unsigned cvt_pk_bf16(float lo, float hi) { f32x2_t v = {lo, hi}; bf16x2_t b = __builtin_convertvector(v, bf16x2_t); return __builtin_bit_cast(unsigned, b); }
struct EpiScaleBf16 {
    static constexpr bool PERM = true, AFTER_DRAIN = false;
    bf16_t* O; int ldc; const float* ss;
    __device__ __forceinline__ void operator()(const f32x4 (&acc)[2][2][4][2], const Unit& u, int wr, int wc, int fr, int fq) const {
        const int row0 = u.pm * BM + wr * 64 + fr, col0 = u.pn * BM + wc * 32 + 8 * fq;
#pragma unroll
        for (int ai = 0; ai < 2; ++ai)
#pragma unroll
            for (int m = 0; m < 4; ++m) { const int row = row0 + ai * HALF + m * 16; const float rs = __builtin_amdgcn_rsqf(ss[row] * (1.0f / 1024.0f) + 1e-6f);
                bf16_t* rowp = O + (size_t)row * ldc + col0;
#pragma unroll
                for (int bj = 0; bj < 2; ++bj) { const f32x4 v0 = acc[ai][bj][m][0] * rs, v1 = acc[ai][bj][m][1] * rs;
                    u32x4 w; w.x = cvt_pk_bf16(v0[0], v0[1]); w.y = cvt_pk_bf16(v0[2], v0[3]); w.z = cvt_pk_bf16(v1[0], v1[1]); w.w = cvt_pk_bf16(v1[2], v1[3]);
                    *(u32x4*)(rowp + bj * HALF) = w; } }
    }
};
struct EpiResid {
    static constexpr bool PERM = false, AFTER_DRAIN = false;
    const float* base; float* out; bf16_t* xb; float* ss;
    __device__ __forceinline__ void operator()(const f32x4 (&acc)[2][2][4][2], const Unit& u, int wr, int wc, int fr, int fq) const {
        typedef unsigned u32x2v __attribute__((ext_vector_type(2)));
        const int row0 = u.pm * BM + wr * 64 + fr, col0 = u.pn * BM + wc * 32 + 4 * fq;
#pragma unroll
        for (int ai = 0; ai < 2; ++ai)
#pragma unroll
            for (int m = 0; m < 4; ++m) { const int row = row0 + ai * HALF + m * 16; const size_t off = (size_t)row * 1024 + col0; float sq = 0.f;
#pragma unroll
                for (int bj = 0; bj < 2; ++bj)
#pragma unroll
                    for (int n = 0; n < 2; ++n) { const size_t o2 = off + bj * HALF + n * 16; const f32x4 o = *(const f32x4*)(base + o2) + acc[ai][bj][m][n];
                        *(f32x4*)(out + o2) = o; sq += (o[0] * o[0] + o[1] * o[1]) + (o[2] * o[2] + o[3] * o[3]);
                        if (xb) { u32x2v w; w.x = cvt_pk_bf16(o[0], o[1]); w.y = cvt_pk_bf16(o[2], o[3]); *(u32x2v*)(xb + o2) = w; } }
                sq += __shfl_xor(sq, 16); sq += __shfl_xor(sq, 32);
                if (fq == 0) atomicAdd(ss + row, sq); }
    }
};
template <class Epi, class Sched, bool ALIGN_EPI = false, bool SP2 = false>
__device__ __forceinline__ void gemm_phase(PG8_LAS unsigned char* lds, const Gemm g, const Sched& S, const Epi& E) {
    const int tid = threadIdx.x, wid = __builtin_amdgcn_readfirstlane(tid >> 6), lane = tid & 63, wr = wid >> 2, wc = wid & 3, fr = lane & 15, fq = lane >> 4;
    const int K = g.K, nt = K / BK;
    unsigned voffA[2], voffB[2];
#pragma unroll
    for (int i = 0; i < 2; ++i) { int R, C; stage_rc(tid * 16 + i * 8192, R, C); const int Rb = Epi::PERM ? ((R & ~31) + perm32(R & 31)) : R;
        voffA[i] = (unsigned)(R * K + C) * 2u; voffB[i] = (unsigned)(Rb * K + C) * 2u; }
    const size_t kstep = (size_t)(BK * 2);
    const size_t hstep = (size_t)HALF * K * 2;
    const size_t tstep = 2 * hstep;
    const unsigned ldsw = (unsigned)wid * 1024u;
    const int aoff = lds_byte(wr * 64 + fr, fq * 8), boff = lds_byte(wc * 32 + fr, fq * 8);
#define PG8_SA(b, h) (((b) * 2 + (h)) * HTB)
#define PG8_SB(b, h) ((4 + (b) * 2 + (h)) * HTB)
#define PG8_STAGE(bufoff, gbase, voff) do { _Pragma("unroll") for (int _i = 0; _i < 2; ++_i) \
        __builtin_amdgcn_global_load_lds((const unsigned*)((const char*)(gbase) + (voff)[_i]), (PG8_LAS unsigned*)(lds + (bufoff) + ldsw + _i * 8192), 16, 0, 0); } while (0)
#define PG8_LDA(dst, b, h) do { _Pragma("unroll") for (int m = 0; m < 4; ++m) _Pragma("unroll") for (int k = 0; k < 2; ++k) dst[m][k] = *(const PG8_LAS bf16x8*)(lds + PG8_SA(b, h) + aoff + m * 2048 + k * 1024); } while (0)
#define PG8_LDB(dst, b, h) do { _Pragma("unroll") for (int n = 0; n < 2; ++n) _Pragma("unroll") for (int k = 0; k < 2; ++k) dst[n][k] = *(const PG8_LAS bf16x8*)(lds + PG8_SB(b, h) + boff + n * 2048 + k * 1024); } while (0)
#define PG8_MMA(ai, bj, At, Bt) do { __builtin_amdgcn_s_setprio(1); _Pragma("unroll") for (int m = 0; m < 4; ++m) _Pragma("unroll") for (int n = 0; n < 2; ++n) _Pragma("unroll") for (int k = 0; k < 2; ++k) \
        acc[ai][bj][m][n] = __builtin_amdgcn_mfma_f32_16x16x32_bf16(Bt[n][k], At[m][k], acc[ai][bj][m][n], 0, 0, 0); __builtin_amdgcn_s_setprio(0); } while (0)
#define PG8_WAIT_V(n) asm volatile("s_waitcnt vmcnt(" #n ")" ::: "memory")
#define PG8_WAIT_L(n) asm volatile("s_waitcnt lgkmcnt(" #n ")" ::: "memory")
#define PG8_BAR __builtin_amdgcn_s_barrier()
#define PG8_SCHED __builtin_amdgcn_sched_barrier(0)
    Unit cur, nxt; int ui = 0;
    if (!S.next(0, cur)) return;
    f32x4 acc[2][2][4][2];
#pragma unroll
    for (int a = 0; a < 2; ++a)
#pragma unroll
        for (int b = 0; b < 2; ++b)
#pragma unroll
            for (int m = 0; m < 4; ++m)
#pragma unroll
                for (int n = 0; n < 2; ++n) acc[a][b][m][n] = (f32x4){0.f, 0.f, 0.f, 0.f};
    bf16x8 At[4][2], B0[2][2], B1[2][2];
    const char* cA = (const char*)g.A + (size_t)cur.pm * tstep; const char* cB = (const char*)g.Bt + (size_t)cur.pn * tstep;
    S.a_ready(cur);
    if constexpr (SP2) {
        PG8_STAGE(PG8_SB(0, 0), cB, voffB); PG8_STAGE(PG8_SB(0, 1), cB + hstep, voffB); PG8_STAGE(PG8_SA(0, 0), cA, voffA); PG8_STAGE(PG8_SA(0, 1), cA + hstep, voffA);
        if (wr == 1) PG8_BAR;
        PG8_WAIT_V(2); PG8_BAR;
        PG8_STAGE(PG8_SB(1, 0), cB + kstep, voffB); PG8_STAGE(PG8_SA(1, 0), cA + kstep, voffA); PG8_STAGE(PG8_SB(1, 1), cB + hstep + kstep, voffB);
        PG8_WAIT_V(6); PG8_BAR;
    } else {
        PG8_STAGE(PG8_SB(0, 0), cB, voffB); PG8_STAGE(PG8_SA(0, 0), cA, voffA); PG8_STAGE(PG8_SB(0, 1), cB + hstep, voffB); PG8_STAGE(PG8_SA(0, 1), cA + hstep, voffA);
        if (wr == 1) PG8_BAR;
        PG8_WAIT_V(4); PG8_BAR;
        PG8_STAGE(PG8_SB(1, 0), cB + kstep, voffB); PG8_STAGE(PG8_SA(1, 0), cA + kstep, voffA); PG8_STAGE(PG8_SB(1, 1), cB + hstep + kstep, voffB);
        PG8_WAIT_V(6); PG8_BAR;
    }
    for (;;) {
        const bool has_next = S.next(ui + 1, nxt);
        const char* nA = has_next ? (const char*)g.A + (size_t)nxt.pm * tstep : cA; const char* nB = has_next ? (const char*)g.Bt + (size_t)nxt.pn * tstep : cB;
        for (int t = 0; t < nt; t += 2) {
            const bool last = (t == nt - 2);
            const char* a1 = cA + (size_t)(t + 1) * kstep;
            const char* a2 = last ? nA : cA + (size_t)(t + 2) * kstep; const char* b2 = last ? nB : cB + (size_t)(t + 2) * kstep;
            const char* a3 = a2 + kstep; const char* b3 = b2 + kstep;
            if (last && has_next) S.a_ready(nxt);
            if constexpr (SP2) {
            PG8_LDB(B0, 0, 0); PG8_LDB(B1, 0, 1); PG8_SCHED; PG8_LDA(At, 0, 0); PG8_STAGE(PG8_SA(1, 1), a1 + hstep, voffA);
            PG8_WAIT_V(8); PG8_WAIT_L(0); PG8_BAR; PG8_MMA(0, 0, At, B0); PG8_MMA(0, 1, At, B1); PG8_BAR; PG8_SCHED;
            PG8_LDA(At, 0, 1); PG8_STAGE(PG8_SB(0, 0), b2, voffB); PG8_STAGE(PG8_SB(0, 1), b2 + hstep, voffB); PG8_STAGE(PG8_SA(0, 0), a2, voffA);
            PG8_WAIT_V(8); PG8_WAIT_L(0); PG8_BAR; PG8_MMA(1, 0, At, B0); PG8_MMA(1, 1, At, B1); PG8_BAR; PG8_SCHED;
            PG8_LDB(B0, 1, 0); PG8_LDB(B1, 1, 1); PG8_SCHED; PG8_LDA(At, 1, 0); PG8_STAGE(PG8_SA(0, 1), a2 + hstep, voffA);
            PG8_WAIT_V(8); PG8_WAIT_L(0); PG8_BAR; PG8_MMA(0, 0, At, B0); PG8_MMA(0, 1, At, B1); PG8_BAR; PG8_SCHED;
            PG8_LDA(At, 1, 1); PG8_STAGE(PG8_SB(1, 0), b3, voffB); PG8_STAGE(PG8_SB(1, 1), b3 + hstep, voffB); PG8_STAGE(PG8_SA(1, 0), a3, voffA);
            PG8_WAIT_V(8); PG8_WAIT_L(0); PG8_BAR; PG8_MMA(1, 0, At, B0); PG8_MMA(1, 1, At, B1); PG8_BAR; PG8_SCHED;
            } else {
            PG8_LDB(B0, 0, 0); PG8_SCHED; PG8_LDA(At, 0, 0); PG8_STAGE(PG8_SA(1, 1), a1 + hstep, voffA);
            PG8_WAIT_L(8); PG8_BAR; PG8_WAIT_L(0); PG8_MMA(0, 0, At, B0); PG8_BAR; PG8_SCHED;
            PG8_LDB(B1, 0, 1); PG8_STAGE(PG8_SB(0, 0), b2, voffB);
            PG8_BAR; PG8_WAIT_L(0); PG8_MMA(0, 1, At, B1); PG8_BAR;
            PG8_LDA(At, 0, 1); PG8_STAGE(PG8_SA(0, 0), a2, voffA);
            PG8_BAR; PG8_WAIT_L(0); PG8_MMA(1, 0, At, B0); PG8_BAR; PG8_SCHED;
            PG8_STAGE(PG8_SB(0, 1), b2 + hstep, voffB);
            PG8_WAIT_V(6); PG8_BAR; PG8_MMA(1, 1, At, B1); PG8_BAR;
            PG8_LDB(B0, 1, 0); PG8_SCHED; PG8_LDA(At, 1, 0); PG8_STAGE(PG8_SA(0, 1), a2 + hstep, voffA);
            PG8_WAIT_L(8); PG8_BAR; PG8_WAIT_L(0); PG8_MMA(0, 0, At, B0); PG8_BAR; PG8_SCHED;
            PG8_LDB(B1, 1, 1); PG8_STAGE(PG8_SB(1, 0), b3, voffB);
            PG8_BAR; PG8_WAIT_L(0); PG8_MMA(0, 1, At, B1); PG8_BAR;
            PG8_LDA(At, 1, 1); PG8_STAGE(PG8_SA(1, 0), a3, voffA);
            PG8_BAR; PG8_WAIT_L(0); PG8_MMA(1, 0, At, B0); PG8_BAR; PG8_SCHED;
            PG8_STAGE(PG8_SB(1, 1), b3 + hstep, voffB);
            PG8_WAIT_V(6); PG8_BAR; PG8_MMA(1, 1, At, B1); PG8_BAR;
            }
        }
        if constexpr (ALIGN_EPI) { if (wr == 0) PG8_BAR; }
        if constexpr (!Epi::AFTER_DRAIN) { E(acc, cur, wr, wc, fr, fq); S.done(cur); }
        if (!has_next) break;
#pragma unroll
        for (int a = 0; a < 2; ++a)
#pragma unroll
            for (int b = 0; b < 2; ++b)
#pragma unroll
                for (int m = 0; m < 4; ++m)
#pragma unroll
                    for (int n = 0; n < 2; ++n) acc[a][b][m][n] = (f32x4){0.f, 0.f, 0.f, 0.f};
        cur = nxt; cA = nA; cB = nB; ++ui;
        if constexpr (ALIGN_EPI) { if (wr == 1) PG8_BAR; }
    }
    PG8_WAIT_V(0);
    if constexpr (!ALIGN_EPI) { if (wr == 0) PG8_BAR; }
    PG8_BAR;
    if constexpr (Epi::AFTER_DRAIN) { E.fused(acc, cur, wr, wc, fr, fq, lds, wid, lane); S.done(cur); }
#undef PG8_SA
#undef PG8_SB
#undef PG8_STAGE
#undef PG8_LDA
#undef PG8_LDB
#undef PG8_MMA
#undef PG8_WAIT_V
#undef PG8_WAIT_L
#undef PG8_BAR
#undef PG8_SCHED
}
}

#ifndef PG8_SP2
#define PG8_SP2 true
#endif
#ifndef PG8_ALIGN
#define PG8_ALIGN true
#endif
#define GAS __attribute__((address_space(1)))
#define LAS __attribute__((address_space(3)))
typedef unsigned short bf16;
typedef unsigned v4u __attribute__((ext_vector_type(4)));
typedef float f32x4 __attribute__((ext_vector_type(4)));
typedef short bf16x8 __attribute__((ext_vector_type(8)));
typedef GAS unsigned gu32;
typedef GAS unsigned long long gu64;
#define RLX_AGENT __ATOMIC_RELAXED, __HIP_MEMORY_SCOPE_AGENT
#define LDS_WAIT() asm volatile("s_waitcnt lgkmcnt(0)" ::: "memory")
#define VM_WAIT() asm volatile("s_waitcnt vmcnt(0)" ::: "memory")
__device__ __forceinline__ unsigned long long rt() { return __builtin_amdgcn_s_memrealtime(); }
__device__ __forceinline__ unsigned f2bf(float f) { unsigned u = __builtin_bit_cast(unsigned, f); return (u + 0x7fffu + ((u >> 16) & 1u)) >> 16; }
__device__ __forceinline__ unsigned pk2(float lo, float hi) { return f2bf(lo) | (f2bf(hi) << 16); }

#define XB_TMO      128
#define XB_XCNT(j)  (256  + 64 * (j))
#define XB_XSUB(j)  (1280 + 64 * (j))
#define XB_XGEN(j)  (2304 + 64 * (j))
#define XB_TOP      3328
#define XB_TOPGEN   3392
#define XCD_BAR_WORDS 3456
#define XB_SPIN_CAP (1u << 18)

__device__ __forceinline__ unsigned xb_ld(unsigned* p)              { return __hip_atomic_load(p, __ATOMIC_RELAXED, __HIP_MEMORY_SCOPE_AGENT); }
__device__ __forceinline__ unsigned xb_add(unsigned* p, unsigned v) { return __hip_atomic_fetch_add(p, v, __ATOMIC_RELAXED, __HIP_MEMORY_SCOPE_AGENT); }
__device__ __forceinline__ unsigned xb_xcc_id() { return (unsigned)__builtin_amdgcn_s_getreg((3 << 11) | 20) & 0xFu; }
#define XB_SPIN(cond, bar) do { unsigned _sp = 0; while (cond) { __builtin_amdgcn_s_sleep(1); \
    if ((++_sp & 255u) == 0u) { if (xb_ld(&(bar)[XB_TMO])) break; if (_sp > XB_SPIN_CAP) { atomicAdd(&(bar)[XB_TMO], 1u); break; } } } } while (0)

struct XcdBarrier {
    unsigned* bar; unsigned x;
    volatile LAS unsigned* st;
};

__device__ __forceinline__ XcdBarrier xcd_barrier_post(unsigned* bar, volatile LAS unsigned* st) {
    XcdBarrier b; b.bar = bar; b.x = xb_xcc_id(); b.st = st;
    if (threadIdx.x == 0) (void)xb_add(&bar[XB_XCNT(b.x)], 1u);
    return b;
}
__device__ __forceinline__ void xcd_barrier_complete(unsigned* bar, unsigned x, unsigned& nloc, unsigned& nx) {
    const unsigned G = gridDim.x * gridDim.y * gridDim.z;
    unsigned sum, cnt, mine, sp = 0u;
    for (;;) {
        sum = 0u; cnt = 0u; mine = 0u;
#pragma unroll
        for (unsigned j = 0; j < 16; ++j) { const unsigned c = xb_ld(&bar[XB_XCNT(j)]); sum += c; cnt += (c > 0u) ? 1u : 0u; mine = (j == x) ? c : mine; }
        if (sum == G) break;
        __builtin_amdgcn_s_sleep(1);
        if ((++sp & 255u) == 0u) { if (xb_ld(&bar[XB_TMO])) break; if (sp > XB_SPIN_CAP) { atomicAdd(&bar[XB_TMO], 1u); break; } }
    }
    nloc = mine > 0u ? mine : 1u; nx = cnt > 0u ? cnt : 1u;
}

__device__ __forceinline__ void xcd_barrier(const XcdBarrier& b) {
    asm volatile("s_waitcnt vmcnt(0)" ::: "memory");
    __syncthreads();
    if (threadIdx.x == 0) {
        unsigned* bar = b.bar;
        __builtin_amdgcn_s_waitcnt(0);
        unsigned nloc = b.st[0], nx = b.st[1];
        if (nloc == 0u) { xcd_barrier_complete(bar, b.x, nloc, nx); b.st[0] = nloc; b.st[1] = nx; }
        const unsigned old = xb_add(&bar[XB_XSUB(b.x)], 1u);
        const unsigned gen = old / nloc;
        if (old + 1u == (gen + 1u) * nloc) {
            __builtin_amdgcn_fence(__ATOMIC_RELEASE, "agent");
            asm volatile("s_waitcnt vmcnt(0)" ::: "memory");
            const unsigned og = xb_add(&bar[XB_TOP], 1u);
            const unsigned tg = og / nx;
            if (og + 1u == (tg + 1u) * nx) xb_add(&bar[XB_TOPGEN], 1u);
            else XB_SPIN(xb_ld(&bar[XB_TOPGEN]) == tg, bar);
            __builtin_amdgcn_fence(__ATOMIC_ACQUIRE, "agent");
            xb_add(&bar[XB_XGEN(b.x)], 1u);
            asm volatile("s_waitcnt vmcnt(0)" ::: "memory");
        } else {
            XB_SPIN(xb_ld(&bar[XB_XGEN(b.x)]) == gen, bar);
            __builtin_amdgcn_fence(__ATOMIC_ACQUIRE, "agent");
            asm volatile("s_waitcnt vmcnt(0)" ::: "memory");
        }
    }
    __syncthreads();
}

__device__ __forceinline__ float bf2f(bf16 v) { return __uint_as_float((unsigned)v << 16); }
__device__ __forceinline__ float silu_f(float x) { return x / (1.f + __expf(-x)); }
__device__ __forceinline__ float sigmoid_f(float x) { return 1.f / (1.f + __expf(-x)); }
__device__ __forceinline__ float logsig_f(float x) { return fminf(x, 0.f) - log1pf(__expf(-fabsf(x))); }
struct WPrep { const float *e_norm, *e_win, *e_pw, *e_ps, *e_wout, *o_norm, *o_win, *o_wout; bf16 *w1, *w2, *w3, *w4; };
__device__ __forceinline__ float wsrc(const WPrep& P, int mat, int k, int n) {
    if (mat == 0) return P.e_norm[k] * P.e_win[(size_t)k * EVEN_IN + n];
    if (mat == 1) return P.e_wout[(size_t)k * D + n];
    if (mat == 2) { int o = n < 2304 ? n : (n < 3328 ? n + 8 : (n < 3336 ? n - 1024 : -1)); return o < 0 ? 0.f : P.o_norm[k] * P.o_win[(size_t)k * ODD_IN + o]; }
    return P.o_wout[(size_t)k * D + n];
}
__device__ __forceinline__ void wprep_item(const WPrep& P, int mat, int kb, int nb, float* scr, int lane) {
    const int k0 = 64 * kb, n0 = 32 * nb;
    bf16* WT = mat == 0 ? P.w1 : mat == 1 ? P.w2 : mat == 2 ? P.w3 : P.w4;
    if (mat == 0 && n0 >= 2048 && n0 < 2560) {
        const int cc0 = n0 - 2048, grp = cc0 >> 7, c0 = cc0 & 127, k = k0 + lane;
        float acc[32];
#pragma unroll
        for (int j = 0; j < 32; ++j) acc[j] = 0.f;
        const float* wrow = P.e_win + (size_t)k * EVEN_IN + 2048 + 128 * grp;
        const float* pw = P.e_pw + (size_t)grp * 128 * 128 + c0;
        for (int j4 = 0; j4 < 32; ++j4) { const float4 a = *(const float4*)(wrow + 4 * j4);
#pragma unroll
            for (int jj = 0; jj < 4; ++jj) { const float av = jj == 0 ? a.x : jj == 1 ? a.y : jj == 2 ? a.z : a.w; const float* pr = pw + (size_t)(4 * j4 + jj) * 128;
#pragma unroll
                for (int c = 0; c < 32; ++c) acc[c] += av * pr[c]; } }
        const float g = P.e_norm[k];
#pragma unroll
        for (int c = 0; c < 32; ++c) scr[lane * 33 + c] = acc[c] * g * P.e_ps[cc0 + c];
    } else {
#pragma unroll 4
        for (int i = 0; i < 32; ++i) { const int kk = 2 * i + (lane >> 5); scr[kk * 33 + (lane & 31)] = wsrc(P, mat, k0 + kk, n0 + (lane & 31)); }
    }
    __builtin_amdgcn_s_waitcnt(0xc07f); __builtin_amdgcn_wave_barrier();
    const int c = lane & 7;
#pragma unroll
    for (int j = 0; j < 4; ++j) { const int n = (lane >> 3) + 8 * j; const float* s = scr + (8 * c) * 33 + n;
        uint4 o; o.x = f2bf(s[0]) | ((unsigned)f2bf(s[33]) << 16); o.y = f2bf(s[66]) | ((unsigned)f2bf(s[99]) << 16);
        o.z = f2bf(s[132]) | ((unsigned)f2bf(s[165]) << 16); o.w = f2bf(s[198]) | ((unsigned)f2bf(s[231]) << 16);
        *(uint4*)(WT + (size_t)(n0 + n) * D + k0 + 8 * c) = o; }
    __builtin_amdgcn_s_waitcnt(0xc07f); __builtin_amdgcn_wave_barrier();
}
constexpr int WI_0 = 16 * (3072 / 32), WI_1 = 16 * 32, WI_2 = 16 * (3584 / 32), WI_3 = 16 * 32, WI_ALL = WI_0 + WI_1 + WI_2 + WI_3;
constexpr int RING_OFF = 0, RING_BYTES = 131072;
constexpr int LDSCTL_OFF = RING_BYTES, MISC_OFF = LDSCTL_OFF + 320;
constexpr int LDS_BYTES = 147456;
constexpr int NWAVES = 8;
constexpr int CW_BAR = 4096;
constexpr int N_PHASES = 9;

__device__ __forceinline__ void prep_x_row(const float* __restrict__ x, bf16* __restrict__ xb, float* __restrict__ ss, int row, int lane) {
    const float4* xr = (const float4*)(x + (size_t)row * D) + lane; float s = 0.f;
    uint2* o = (uint2*)(xb + (size_t)row * D) + lane;
#pragma unroll
    for (int j = 0; j < 4; ++j) { const float4 v = xr[64 * j]; s += v.x * v.x + v.y * v.y + v.z * v.z + v.w * v.w;
        uint2 w; w.x = pg8::cvt_pk_bf16(v.x, v.y); w.y = pg8::cvt_pk_bf16(v.z, v.w); o[64 * j] = w; }
#pragma unroll
    for (int m = 1; m < 64; m <<= 1) s += __shfl_xor(s, m);
    if (lane == 0) ss[row] = s;
}
__device__ __forceinline__ void final_row(float* __restrict__ out, const float* __restrict__ ss, const float* __restrict__ g, int row, int lane) {
    float4* xr = (float4*)(out + (size_t)row * D) + lane; const float rs = rsqrtf(ss[row] * (1.f / D) + RMS_EPS);
#pragma unroll
    for (int j = 0; j < 4; ++j) { float4 v = xr[64 * j]; const float4 gv = ((const float4*)g)[lane + 64 * j];
        v.x *= rs * gv.x; v.y *= rs * gv.y; v.z *= rs * gv.z; v.w *= rs * gv.w; xr[64 * j] = v; }
}
__device__ __forceinline__ void unpack8(const uint4 v, float (&f)[8]) {
    f[0] = __uint_as_float(v.x << 16); f[1] = __uint_as_float(v.x & 0xffff0000u); f[2] = __uint_as_float(v.y << 16); f[3] = __uint_as_float(v.y & 0xffff0000u);
    f[4] = __uint_as_float(v.z << 16); f[5] = __uint_as_float(v.z & 0xffff0000u); f[6] = __uint_as_float(v.w << 16); f[7] = __uint_as_float(v.w & 0xffff0000u);
}
__device__ __forceinline__ uint4 pack8(const float (&f)[8]) { uint4 o; o.x = pg8::cvt_pk_bf16(f[0], f[1]); o.y = pg8::cvt_pk_bf16(f[2], f[3]); o.z = pg8::cvt_pk_bf16(f[4], f[5]); o.w = pg8::cvt_pk_bf16(f[6], f[7]); return o; }
constexpr int EM_RUN = 16;
__device__ __forceinline__ void even_mix_unit(const bf16* __restrict__ PB, const float* __restrict__ cw, bf16* __restrict__ YB, int unit, int lane) {
    const int half = unit & 1, t0 = (unit >> 1) * EM_RUN, c8 = lane * 8;
    if (half == 0) {
        const bf16* p = PB + (size_t)t0 * EVEN_IN + c8;
        float w0[8], w1[8], w2[8], u1[8], u2[8];
#pragma unroll
        for (int i = 0; i < 8; ++i) { w0[i] = cw[c8 + i]; w1[i] = cw[512 + c8 + i]; w2[i] = cw[1024 + c8 + i]; u1[i] = 0.f; u2[i] = 0.f; }
        if (t0 > 0) { float a[8], b[8];
            unpack8(*(const uint4*)(p - 2 * EVEN_IN), a); unpack8(*(const uint4*)(p - 2 * EVEN_IN + 1024), b);
#pragma unroll
            for (int i = 0; i < 8; ++i) u2[i] = a[i] * b[i];
            unpack8(*(const uint4*)(p - EVEN_IN), a); unpack8(*(const uint4*)(p - EVEN_IN + 1024), b);
#pragma unroll
            for (int i = 0; i < 8; ++i) u1[i] = a[i] * b[i]; }
#pragma unroll 4
        for (int t = 0; t < EM_RUN; ++t) { const bf16* q = p + (size_t)t * EVEN_IN; float xa[8], bg[8], cg[8], ga[8], y[8];
            unpack8(*(const uint4*)q, xa); unpack8(*(const uint4*)(q + 512), bg); unpack8(*(const uint4*)(q + 1024), cg); unpack8(*(const uint4*)(q + 1536), ga);
#pragma unroll
            for (int i = 0; i < 8; ++i) { const float u0 = cg[i] * xa[i]; y[i] = bg[i] * (w0[i] * u2[i] + w1[i] * u1[i] + w2[i] * u0) * silu_f(ga[i]); u2[i] = u1[i]; u1[i] = u0; }
            *(uint4*)(YB + (size_t)(t0 + t) * D + c8) = pack8(y); }
    } else {
        const int w = 2 << (lane >> 4); const bf16* p = PB + (size_t)t0 * EVEN_IN + 2048 + c8; float sum[8];
#pragma unroll
        for (int i = 0; i < 8; ++i) sum[i] = 0.f;
        for (int j = 1; j < 16; ++j) if (j < w && t0 - j >= 0) { float a[8]; unpack8(*(const uint4*)(p - j * EVEN_IN), a);
#pragma unroll
            for (int i = 0; i < 8; ++i) sum[i] += a[i]; }
#pragma unroll 4
        for (int t = 0; t < EM_RUN; ++t) { const bf16* q = p + (size_t)t * EVEN_IN; float u[8], gb[8], old[8], y[8]; const int tt = t0 + t, tb = tt - (w - 1);
            unpack8(*(const uint4*)q, u); unpack8(*(const uint4*)(q + 512), gb);
            if (tb >= 0) unpack8(*(const uint4*)(q - (w - 1) * EVEN_IN), old); else {
#pragma unroll
                for (int i = 0; i < 8; ++i) old[i] = 0.f; }
            const float inv = 1.f / (float)(tt + 1 < w ? tt + 1 : w);
#pragma unroll
            for (int i = 0; i < 8; ++i) { sum[i] += u[i]; y[i] = (sum[i] * inv - u[i]) * silu_f(gb[i]); sum[i] -= old[i]; }
            *(uint4*)(YB + (size_t)tt * D + 512 + c8) = pack8(y); }
    }
}

typedef float f32x16 __attribute__((ext_vector_type(16)));
typedef unsigned u32x2 __attribute__((ext_vector_type(2)));
#define MFMA32(a, b, c) __builtin_amdgcn_mfma_f32_32x32x16_bf16((a), (b), (c), 0, 0, 0)
__device__ __forceinline__ int crow(int i, int h) { return (i & 3) + 8 * (i >> 2) + 4 * h; }
__device__ __forceinline__ bf16x8 pack8_acc(const f32x16& x, int s) {
    pg8::u32x4 p; p.x = pg8::cvt_pk_bf16(x[8 * s], x[8 * s + 1]); p.y = pg8::cvt_pk_bf16(x[8 * s + 2], x[8 * s + 3]); p.z = pg8::cvt_pk_bf16(x[8 * s + 4], x[8 * s + 5]); p.w = pg8::cvt_pk_bf16(x[8 * s + 6], x[8 * s + 7]);
    return __builtin_bit_cast(bf16x8, p);
}
constexpr int AT_KP = 144, AT_VP = 520, AT_K_OFF = 0, AT_V_OFF = 256 * AT_KP, AT_END = AT_V_OFF + 64 * AT_VP;
static_assert(AT_END <= RING_BYTES, "attention LDS");
__device__ __forceinline__ void attn_unit(LAS unsigned char* L, const bf16* __restrict__ PB, const float* __restrict__ sinks, bf16* __restrict__ YB, int nb, int g, int tid, int lane, int wave) {
    const int tokb = (nb - 1) * 128;
#pragma unroll
    for (int i = 0; i < 4; ++i) { const int c = tid + 512 * i, row = c >> 3, ch = c & 7, tok = tokb + row; uint4 v = {0u, 0u, 0u, 0u};
        if (tok >= 0) v = *(const uint4*)(PB + (size_t)tok * ODD_PAD + O_K + g * 64 + ch * 8);
        *(LAS pg8::u32x4*)(L + AT_K_OFF + row * AT_KP + ch * 16) = (pg8::u32x4){v.x, v.y, v.z, v.w}; }
#pragma unroll
    for (int i = 0; i < 2; ++i) { const int kp = tid & 127, ch = (tid >> 7) + 4 * i, tok = tokb + 2 * kp; uint4 v0 = {0u, 0u, 0u, 0u}, v1 = {0u, 0u, 0u, 0u};
        if (tok >= 0) { const bf16* src = PB + (size_t)tok * ODD_PAD + O_V + g * 64 + ch * 8; v0 = *(const uint4*)src; v1 = *(const uint4*)(src + ODD_PAD); }
        const unsigned a[4] = {v0.x, v0.y, v0.z, v0.w}, b[4] = {v1.x, v1.y, v1.z, v1.w};
#pragma unroll
        for (int e = 0; e < 4; ++e) { LAS unsigned char* dst = L + AT_V_OFF + (ch * 8 + 2 * e) * AT_VP + kp * 4;
            *(LAS unsigned*)dst = (a[e] & 0xffffu) | (b[e] << 16); *(LAS unsigned*)(dst + AT_VP) = (a[e] >> 16) | (b[e] & 0xffff0000u); } }
    __syncthreads();
    const int hq = 4 * g + (wave >> 1), rh = wave & 1, c = lane & 31, h = lane >> 5;
    const float slope = exp2f(-(float)(hq + 1)), sink = sinks[hq];
#pragma unroll 1
    for (int j = 0; j < 2; ++j) {
        const int q0 = 64 * rh + 32 * j, kt0 = q0 >> 5, t = nb * 128 + q0 + c;
        bf16x8 qf[4];
#pragma unroll
        for (int ks = 0; ks < 4; ++ks) qf[ks] = *(const bf16x8*)(PB + (size_t)t * ODD_PAD + O_Q + hq * 64 + 16 * ks + 8 * h);
        f32x16 p[5];
#pragma unroll
        for (int kk = 0; kk < 5; ++kk) { f32x16 acc;
#pragma unroll
            for (int i = 0; i < 16; ++i) acc[i] = 0.f;
            const LAS unsigned char* kp = L + AT_K_OFF + (32 * (kt0 + kk) + c) * AT_KP + 16 * h;
#pragma unroll
            for (int ks = 0; ks < 4; ++ks) acc = MFMA32(*(const LAS bf16x8*)(kp + 32 * ks), qf[ks], acc);
            p[kk] = acc; __builtin_amdgcn_sched_barrier(0); }
        int cbh = c + 128 - 4 * h; asm volatile("" : "+v"(cbh));
        const int tq = q0 + c; const unsigned lim = nb > 0 ? 127u : (unsigned)tq;
        const float base = -slope * (float)cbh; float mx = sink;
#pragma unroll
        for (int kk = 0; kk < 5; ++kk)
#pragma unroll
            for (int i = 0; i < 16; ++i) { const int kc = 32 * kk + (i & 3) + 8 * (i >> 2); const unsigned dist = (unsigned)(cbh - kc);
                const float s = dist <= lim ? fmaf(slope, (float)kc, fmaf(p[kk][i], 0.125f, base)) : -1e30f; p[kk][i] = s; mx = fmaxf(mx, s); }
        mx = fmaxf(mx, __shfl_xor(mx, 32));
        float l = 0.f;
#pragma unroll
        for (int kk = 0; kk < 5; ++kk)
#pragma unroll
            for (int i = 0; i < 16; ++i) { const float e = __expf(p[kk][i] - mx); p[kk][i] = e; l += e; }
        l += __shfl_xor(l, 32); l += __expf(sink - mx);
        f32x16 o[2];
#pragma unroll
        for (int i = 0; i < 16; ++i) { o[0][i] = 0.f; o[1][i] = 0.f; }
#pragma unroll
        for (int kk = 0; kk < 5; ++kk)
#pragma unroll
            for (int s = 0; s < 2; ++s) { const bf16x8 pb = pack8_acc(p[kk], s); const int kb = 32 * (kt0 + kk) + 16 * s + 4 * h;
#pragma unroll
                for (int dt = 0; dt < 2; ++dt) { const LAS unsigned char* vp = L + AT_V_OFF + (32 * dt + c) * AT_VP + kb * 2;
                    const u32x2 lo = *(const LAS u32x2*)vp, hi = *(const LAS u32x2*)(vp + 16); const pg8::u32x4 av = {lo.x, lo.y, hi.x, hi.y};
                    o[dt] = MFMA32(__builtin_bit_cast(bf16x8, av), pb, o[dt]); }
                __builtin_amdgcn_sched_barrier(0); }
        const float il = 1.f / l; const bf16* grow = PB + (size_t)t * ODD_PAD + O_GC + hq * 64; bf16* yrow = YB + (size_t)t * D + hq * 64;
#pragma unroll
        for (int dt = 0; dt < 2; ++dt)
#pragma unroll
            for (int iq = 0; iq < 4; ++iq) { const int d = 32 * dt + 8 * iq + 4 * h; const uint2 gv = *(const uint2*)(grow + d);
                const float g0 = __uint_as_float(gv.x << 16), g1 = __uint_as_float(gv.x & 0xffff0000u), g2 = __uint_as_float(gv.y << 16), g3 = __uint_as_float(gv.y & 0xffff0000u);
                uint2 w; w.x = pg8::cvt_pk_bf16(o[dt][4 * iq] * il * silu_f(g0), o[dt][4 * iq + 1] * il * silu_f(g1)); w.y = pg8::cvt_pk_bf16(o[dt][4 * iq + 2] * il * silu_f(g2), o[dt][4 * iq + 3] * il * silu_f(g3));
                *(uint2*)(yrow + d) = w; }
    }
    __syncthreads();
}

__device__ __forceinline__ float scan256_add(float v, LAS float* tmp, int lane, int wave) {
#pragma unroll
    for (int d = 1; d < 64; d <<= 1) { const float u = __shfl_up(v, d); if (lane >= d) v += u; }
    if (wave < 4 && lane == 63) tmp[wave] = v;
    __syncthreads();
    float off = 0.f;
#pragma unroll
    for (int w2 = 0; w2 < 3; ++w2) if (w2 < wave) off += tmp[w2];
    __syncthreads();
    return v + off;
}
__device__ __forceinline__ float scan256_max(float v, LAS float* tmp, int lane, int wave) {
#pragma unroll
    for (int d = 1; d < 64; d <<= 1) { const float u = __shfl_up(v, d); if (lane >= d) v = fmaxf(v, u); }
    if (wave < 4 && lane == 63) tmp[wave] = v;
    __syncthreads();
    float off = -INFINITY;
#pragma unroll
    for (int w2 = 0; w2 < 3; ++w2) if (w2 < wave) off = fmaxf(off, tmp[w2]);
    __syncthreads();
    return fmaxf(v, off);
}
template <int NCH_PER_THREAD> __device__ __forceinline__ void stage_transposed(LAS unsigned char* img, int pitch, const bf16* __restrict__ src, int tid) {
#pragma unroll
    for (int i = 0; i < NCH_PER_THREAD; ++i) { const int kp = tid & 127, ch = (tid >> 7) + 4 * i; const bf16* s = src + (size_t)(2 * kp) * ODD_PAD + ch * 8;
        const uint4 v0 = *(const uint4*)s, v1 = *(const uint4*)(s + ODD_PAD); const unsigned a[4] = {v0.x, v0.y, v0.z, v0.w}, b[4] = {v1.x, v1.y, v1.z, v1.w};
#pragma unroll
        for (int e = 0; e < 4; ++e) { LAS unsigned char* dst = img + (ch * 8 + 2 * e) * pitch + kp * 4;
            *(LAS unsigned*)dst = (a[e] & 0xffffu) | (b[e] << 16); *(LAS unsigned*)(dst + pitch) = (a[e] >> 16) | (b[e] & 0xffff0000u); } }
}
constexpr int MA_P = 528, MA_K_OFF = 0, MA_V_OFF = 64 * MA_P, MA_W_OFF = MA_V_OFF + 128 * MA_P, MA_TMP = MA_W_OFF + 1024, MA_END = MA_TMP + 64;
static_assert(MA_END <= RING_BYTES, "mLSTM phase A LDS");
__device__ __forceinline__ void mlstm_a_unit(LAS unsigned char* L, const bf16* __restrict__ PB, const float* __restrict__ ibp, const float* __restrict__ fbp, float* __restrict__ cloc, float* __restrict__ msc, int sc, int hh, int tid, int lane, int wave) {
    const bf16* base = PB + (size_t)sc * SC * ODD_PAD;
    LAS float* wS = (LAS float*)(L + MA_W_OFF); LAS float* tmp = (LAS float*)(L + MA_TMP);
    float lf = 0.f, ipre = 0.f;
    if (tid < 256) { const bf16* r = base + (size_t)tid * ODD_PAD; lf = logsig_f(bf2f(r[O_DF + hh]) + fbp[hh]); ipre = bf2f(r[O_DI + hh]) + ibp[hh]; }
    const float bl = scan256_add(lf, tmp, lane, wave), al = tid < 256 ? ipre - bl : -INFINITY;
    float am = al;
#pragma unroll
    for (int m = 1; m < 64; m <<= 1) am = fmaxf(am, __shfl_xor(am, m));
    if (lane == 0) tmp[wave] = am;
    __syncthreads();
    am = fmaxf(fmaxf(tmp[0], tmp[1]), fmaxf(tmp[2], tmp[3]));
    if (tid < 256) wS[tid] = __expf(al - am);
    if (tid == 255) msc[(sc * 4 + hh) * 2] = bl;
    if (tid == 0) msc[(sc * 4 + hh) * 2 + 1] = am;
    __syncthreads();
#pragma unroll
    for (int i = 0; i < 2; ++i) { const int kp = tid & 127, ch = (tid >> 7) + 4 * i; const bf16* s = base + (size_t)(2 * kp) * ODD_PAD + O_DK + hh * 64 + ch * 8;
        const uint4 v0 = *(const uint4*)s, v1 = *(const uint4*)(s + ODD_PAD); const unsigned a[4] = {v0.x, v0.y, v0.z, v0.w}, b[4] = {v1.x, v1.y, v1.z, v1.w}; const float w0 = wS[2 * kp], w1 = wS[2 * kp + 1];
#pragma unroll
        for (int e = 0; e < 4; ++e) { LAS unsigned char* dst = L + MA_K_OFF + (ch * 8 + 2 * e) * MA_P + kp * 4;
            *(LAS unsigned*)dst = pg8::cvt_pk_bf16(w0 * __uint_as_float(a[e] << 16), w1 * __uint_as_float(b[e] << 16));
            *(LAS unsigned*)(dst + MA_P) = pg8::cvt_pk_bf16(w0 * __uint_as_float(a[e] & 0xffff0000u), w1 * __uint_as_float(b[e] & 0xffff0000u)); } }
    stage_transposed<4>(L + MA_V_OFF, MA_P, base + O_DV + hh * 128, tid);
    __syncthreads();
    const int mt = wave >> 2, nt = wave & 3, c = lane & 31, h2 = lane >> 5;
    f32x16 acc, accn;
#pragma unroll
    for (int i = 0; i < 16; ++i) { acc[i] = 0.f; accn[i] = 0.f; }
    const LAS unsigned char* ap = L + MA_K_OFF + (32 * mt + c) * MA_P + 16 * h2; const LAS unsigned char* bp = L + MA_V_OFF + (32 * nt + c) * MA_P + 16 * h2;
    const pg8::u32x4 ones_u = {0x3f803f80u, 0x3f803f80u, 0x3f803f80u, 0x3f803f80u}; const bf16x8 ones = __builtin_bit_cast(bf16x8, ones_u);
#pragma unroll 4
    for (int ks = 0; ks < 16; ++ks) { const bf16x8 a = *(const LAS bf16x8*)(ap + 32 * ks), b = *(const LAS bf16x8*)(bp + 32 * ks);
        acc = MFMA32(a, b, acc); if (nt == 0) accn = MFMA32(a, ones, accn); }
    float* out = cloc + (size_t)(sc * 4 + hh) * CLOC_STRIDE;
#pragma unroll
    for (int i = 0; i < 16; ++i) out[(32 * mt + crow(i, h2)) * 128 + 32 * nt + c] = acc[i];
    if (nt == 0 && c == 0) {
#pragma unroll
        for (int i = 0; i < 16; ++i) out[8192 + 32 * mt + crow(i, h2)] = accn[i]; }
    __syncthreads();
}
constexpr int MC_KP = 144, MC_VP = 520, MC_K_OFF = 0, MC_V_OFF = 256 * MC_KP, MC_C_OFF = MC_V_OFF + 128 * MC_VP, MC_AL = MC_C_OFF + 128 * MC_KP, MC_ML = MC_AL + 1024, MC_BL = MC_ML + 1024,
              MC_NST = MC_BL + 1024, MC_COEF = MC_NST + 256, MC_TMP = MC_COEF + 256, MC_END = MC_TMP + 64;
static_assert(MC_END <= RING_BYTES && MC_AL % 16 == 0, "mLSTM phase C LDS");
__device__ __forceinline__ void mlstm_c_unit(LAS unsigned char* L, const bf16* __restrict__ PB, const float* __restrict__ ibp, const float* __restrict__ fbp, const float* __restrict__ cloc, const float* __restrict__ msc, bf16* __restrict__ YB, int sc, int hh, int tid, int lane, int wave) {
    const bf16* base = PB + (size_t)sc * SC * ODD_PAD;
    LAS float* alS = (LAS float*)(L + MC_AL); LAS float* MlS = (LAS float*)(L + MC_ML); LAS float* blS = (LAS float*)(L + MC_BL); LAS float* nst = (LAS float*)(L + MC_NST);
    LAS float* coefS = (LAS float*)(L + MC_COEF); LAS float* tmp = (LAS float*)(L + MC_TMP);
    if (wave == 0) { const int j = lane; const bool in = j < sc; float b = 0.f, am = 0.f;
        if (in) { b = msc[(j * 4 + hh) * 2]; am = msc[(j * 4 + hh) * 2 + 1]; }
        float Bs = in ? b : 0.f, Cs = in ? b + am : -INFINITY;
#pragma unroll
        for (int d = 1; d < 64; d <<= 1) { const float Bu = __shfl_up(Bs, d), Cu = __shfl_up(Cs, d); if (lane >= d) { Cs = fmaxf(Cu + Bs, Cs); Bs = Bu + Bs; } }
        const float Btot = __shfl(Bs, 63), Ctot = __shfl(Cs, 63), ms = fmaxf(Btot, Ctot);
        coefS[lane] = in ? __expf(Btot - Bs + b + am - ms) : 0.f;
        if (lane == 0) tmp[8] = ms; }
    float lf = 0.f, ipre = 0.f;
    if (tid < 256) { const bf16* r = base + (size_t)tid * ODD_PAD; lf = logsig_f(bf2f(r[O_DF + hh]) + fbp[hh]); ipre = bf2f(r[O_DI + hh]) + ibp[hh]; }
    const float bl = scan256_add(lf, tmp, lane, wave), al = tid < 256 ? ipre - bl : -INFINITY;
    const float ms_in = tmp[8];
    const float cm = scan256_max(al, tmp, lane, wave);
    if (tid < 256) { alS[tid] = al; blS[tid] = bl; MlS[tid] = fmaxf(ms_in, cm); }
    { const int dv = tid & 127, g4 = tid >> 7; float a[16], na = 0.f;
#pragma unroll
        for (int e = 0; e < 16; ++e) a[e] = 0.f;
        for (int j = sc - 1; j >= 0; --j) { const float cf = coefS[j]; if (cf == 0.f) continue;
            const float* src = cloc + (size_t)(j * 4 + hh) * CLOC_STRIDE;
#pragma unroll
            for (int e = 0; e < 16; ++e) a[e] += cf * src[(16 * g4 + e) * 128 + dv];
            if (tid < 64) na += cf * src[8192 + tid]; }
#pragma unroll
        for (int e2 = 0; e2 < 8; ++e2) *(LAS unsigned*)(L + MC_C_OFF + dv * MC_KP + (16 * g4 + 2 * e2) * 2) = pg8::cvt_pk_bf16(a[2 * e2], a[2 * e2 + 1]);
        if (tid < 64) nst[tid] = na; }
#pragma unroll
    for (int i = 0; i < 4; ++i) { const int cidx = tid + 512 * i, row = cidx >> 3, ch = cidx & 7; const uint4 v = *(const uint4*)(base + (size_t)row * ODD_PAD + O_DK + hh * 64 + ch * 8);
        *(LAS pg8::u32x4*)(L + MC_K_OFF + row * MC_KP + ch * 16) = (pg8::u32x4){v.x, v.y, v.z, v.w}; }
    stage_transposed<4>(L + MC_V_OFF, MC_VP, base + O_DV + hh * 128, tid);
    __syncthreads();
    const int c = lane & 31, h2 = lane >> 5, t = 32 * wave + c; const bf16* row = base + (size_t)t * ODD_PAD;
    bf16x8 qf[4];
#pragma unroll
    for (int ks = 0; ks < 4; ++ks) qf[ks] = *(const bf16x8*)(row + O_DQ + hh * 64 + 16 * ks + 8 * h2);
    f32x16 o[4];
#pragma unroll
    for (int dt = 0; dt < 4; ++dt) {
#pragma unroll
        for (int i = 0; i < 16; ++i) o[dt][i] = 0.f;
        const LAS unsigned char* ap = L + MC_C_OFF + (32 * dt + c) * MC_KP + 16 * h2;
#pragma unroll
        for (int ks = 0; ks < 4; ++ks) o[dt] = MFMA32(*(const LAS bf16x8*)(ap + 32 * ks), qf[ks], o[dt]); }
    const float Ml = MlS[t], ex = __expf(ms_in - Ml) * 0.125f;
#pragma unroll
    for (int dt = 0; dt < 4; ++dt) o[dt] = o[dt] * ex;
    float dq = 0.f;
#pragma unroll
    for (int ks = 0; ks < 4; ++ks)
#pragma unroll
        for (int e = 0; e < 8; ++e) dq += bf2f((bf16)qf[ks][e]) * nst[16 * ks + 8 * h2 + e];
    dq += __shfl_xor(dq, 32);
    float psum = 0.f;
    for (int kt = 0; kt <= wave; ++kt) {
        f32x16 acc;
#pragma unroll
        for (int i = 0; i < 16; ++i) acc[i] = 0.f;
        const LAS unsigned char* kp = L + MC_K_OFF + (32 * kt + c) * MC_KP + 16 * h2;
#pragma unroll
        for (int ks = 0; ks < 4; ++ks) acc = MFMA32(*(const LAS bf16x8*)(kp + 32 * ks), qf[ks], acc);
        const bool diag = kt == wave;
#pragma unroll
        for (int iq = 0; iq < 4; ++iq) { const pg8::f32x4 a4 = *(const LAS pg8::f32x4*)(alS + 32 * kt + 8 * iq + 4 * h2);
#pragma unroll
            for (int e = 0; e < 4; ++e) { const int srel = 8 * iq + 4 * h2 + e; const float wgt = __expf(a4[e] - Ml) * 0.125f;
                const float p = (!diag || srel <= c) ? acc[4 * iq + e] * wgt : 0.f; acc[4 * iq + e] = p; psum += p; } }
#pragma unroll
        for (int s = 0; s < 2; ++s) { const bf16x8 pb = pack8_acc(acc, s); const int kb = 32 * kt + 16 * s + 4 * h2;
#pragma unroll
            for (int dt = 0; dt < 4; ++dt) { const LAS unsigned char* vp = L + MC_V_OFF + (32 * dt + c) * MC_VP + kb * 2;
                const u32x2 lo = *(const LAS u32x2*)vp, hi = *(const LAS u32x2*)(vp + 16); const pg8::u32x4 av = {lo.x, lo.y, hi.x, hi.y};
                o[dt] = MFMA32(__builtin_bit_cast(bf16x8, av), pb, o[dt]); } }
        __builtin_amdgcn_sched_barrier(0);
    }
    psum += __shfl_xor(psum, 32);
    const float den = ex * dq + psum, inv = 1.f / fmaxf(fabsf(den), __expf(-(blS[t] + Ml)));
    const bf16* orow = row + O_DO + hh * 128; const bf16* grow = row + O_GD + hh * 128; bf16* yrow = YB + (size_t)(sc * SC + t) * D + 512 + hh * 128;
#pragma unroll
    for (int dt = 0; dt < 4; ++dt)
#pragma unroll
        for (int iq = 0; iq < 4; ++iq) { const int d = 32 * dt + 8 * iq + 4 * h2; const uint2 ov = *(const uint2*)(orow + d), gv = *(const uint2*)(grow + d);
            const float o0 = __uint_as_float(ov.x << 16), o1 = __uint_as_float(ov.x & 0xffff0000u), o2 = __uint_as_float(ov.y << 16), o3 = __uint_as_float(ov.y & 0xffff0000u);
            const float g0 = __uint_as_float(gv.x << 16), g1 = __uint_as_float(gv.x & 0xffff0000u), g2 = __uint_as_float(gv.y << 16), g3 = __uint_as_float(gv.y & 0xffff0000u);
            uint2 w; w.x = pg8::cvt_pk_bf16(o[dt][4 * iq] * inv * sigmoid_f(o0) * silu_f(g0), o[dt][4 * iq + 1] * inv * sigmoid_f(o1) * silu_f(g1));
            w.y = pg8::cvt_pk_bf16(o[dt][4 * iq + 2] * inv * sigmoid_f(o2) * silu_f(g2), o[dt][4 * iq + 3] * inv * sigmoid_f(o3) * silu_f(g3));
            *(uint2*)(yrow + d) = w; }
    __syncthreads();
}

struct Args { const float* in[14]; float* out; unsigned char* ws; int ph_lo, ph_hi, li, pad; };
__global__ void __launch_bounds__(NWAVES * 64, 2) mk_fwd(Args args) {
    extern __shared__ __attribute__((aligned(16))) unsigned char lds[];
    LAS unsigned char* const L = (LAS unsigned char*)lds;
    volatile LAS unsigned* const MISC = (volatile LAS unsigned*)(L + MISC_OFF);
    const int tid = threadIdx.x, lane = tid & 63, wave = __builtin_amdgcn_readfirstlane(tid >> 6);
    const int G = gridDim.x, bx = blockIdx.x, vcu = (G % 8 == 0) ? (bx % 8) * (G / 8) + bx / 8 : bx;
    unsigned char* ws = args.ws; gu32* ctl = (gu32*)(ws + WS_CTL);
    const float* x = args.in[0]; float* out = args.out;
    float* ss0 = (float*)(ws + WS_SS0); float* ss1 = (float*)(ws + WS_CTL + 65536); float* ss2 = (float*)(ws + WS_CTL + 131072);
    bf16 *W1 = (bf16*)(ws + WS_W1), *W2 = (bf16*)(ws + WS_W2), *W3 = (bf16*)(ws + WS_W3), *W4 = (bf16*)(ws + WS_W4), *XB = (bf16*)(ws + WS_XB), *YB = (bf16*)(ws + WS_YB), *PB = (bf16*)(ws + WS_PB);
    for (int u = tid; u < (LDS_BYTES - LDSCTL_OFF) / 4; u += NWAVES * 64) ((LAS unsigned*)(L + LDSCTL_OFF))[u] = 0u;
    __syncthreads();
    const int lo = args.ph_lo, hi = args.ph_hi;
    XcdBarrier bar; bar.bar = (unsigned*)(ctl + CW_BAR) + args.li * XCD_BAR_WORDS; bar.x = 0; bar.st = nullptr;
    if (hi - lo > 1) bar = xcd_barrier_post((unsigned*)(ctl + CW_BAR) + args.li * XCD_BAR_WORDS, MISC + 8);
#define IN(k) (lo <= (k) && (k) < hi)
#define SEAM(k) do { if (IN(k) && IN((k) + 1)) xcd_barrier(bar); } while (0)
    const int gw = vcu * NWAVES + wave, NGW = G * NWAVES;

    if (IN(0)) {
        WPrep P{args.in[1], args.in[2], args.in[4], args.in[5], args.in[6], args.in[7], args.in[8], args.in[12], W1, W2, W3, W4};
        float* scr = (float*)(lds + RING_OFF + wave * 16384);
        for (int it = gw; it < WI_ALL; it += NGW) {
            int r = it, mat, nblk;
            if (r < WI_0) { mat = 0; nblk = 96; } else if ((r -= WI_0) < WI_1) { mat = 1; nblk = 32; } else if ((r -= WI_1) < WI_2) { mat = 2; nblk = 112; } else { r -= WI_2; mat = 3; nblk = 32; }
            wprep_item(P, mat, r / nblk, r % nblk, scr, lane);
        }
        for (int row = gw; row < S; row += NGW) prep_x_row(x, XB, ss0, row, lane);
    }
    SEAM(0);
    if (IN(1)) {
        pg8::Gemm g{XB, W1, S, EVEN_IN, D}; pg8::StaticOrder So; So.init(S, EVEN_IN, G, bx);
        pg8::EpiScaleBf16 E{PB, EVEN_IN, ss0};
        pg8::gemm_phase<pg8::EpiScaleBf16, pg8::StaticOrder, PG8_ALIGN, PG8_SP2>(L + RING_OFF, g, So, E);
    }
    SEAM(1);
    if (IN(2)) { for (int u = gw; u < (S / EM_RUN) * 2; u += NGW) even_mix_unit(PB, args.in[3], YB, u, lane); }
    SEAM(2);
    if (IN(3)) {
        pg8::Gemm g{YB, W2, S, D, D}; pg8::StaticOrder So; So.init(S, D, G, bx);
        pg8::EpiResid E{x, out, XB, ss1};
        pg8::gemm_phase<pg8::EpiResid, pg8::StaticOrder, false, PG8_SP2>(L + RING_OFF, g, So, E);
    }
    SEAM(3);
    if (IN(4)) {
        pg8::Gemm g{XB, W3, S, ODD_PAD, D}; pg8::StaticOrder So; So.init(S, ODD_PAD, G, bx);
        pg8::EpiScaleBf16 E{PB, ODD_PAD, ss1};
        pg8::gemm_phase<pg8::EpiScaleBf16, pg8::StaticOrder, PG8_ALIGN, PG8_SP2>(L + RING_OFF, g, So, E);
    }
    SEAM(4);
    float* cloc = (float*)(ws + WS_CLOC); float* msc = (float*)(ws + WS_MSC);
    if (IN(5)) { for (int u = bx; u < 256; u += G) { attn_unit(L + RING_OFF, PB, args.in[11], YB, u >> 1, u & 1, tid, lane, wave);
                                                     mlstm_a_unit(L + RING_OFF, PB, args.in[9], args.in[10], cloc, msc, u >> 2, u & 3, tid, lane, wave); } }
    SEAM(5);
    if (IN(6)) { for (int u = bx; u < 256; u += G) mlstm_c_unit(L + RING_OFF, PB, args.in[9], args.in[10], cloc, msc, YB, u >> 2, u & 3, tid, lane, wave); }
    SEAM(6);
    if (IN(7)) {
        pg8::Gemm g{YB, W4, S, D, D}; pg8::StaticOrder So; So.init(S, D, G, bx);
        pg8::EpiResid E{out, out, nullptr, ss2};
        pg8::gemm_phase<pg8::EpiResid, pg8::StaticOrder, false, PG8_SP2>(L + RING_OFF, g, So, E);
    }
    SEAM(7);
    if (IN(8)) { for (int row = gw; row < S; row += NGW) final_row(out, ss2, args.in[13], row, lane); }
#undef IN
#undef SEAM
}
extern "C" void kernel_launch(void* const* d_in, const int* in_sizes, int n_in, void* d_out, int out_size, void* d_ws, size_t ws_size, hipStream_t stream) {
    static int grid = 0;
    if (grid == 0) {
        if (n_in != 14 || in_sizes[0] != S * D || out_size != S * D || ws_size < WS_END) { fprintf(stderr, "kernel_launch: unexpected shapes (n_in %d out %d ws %zu)\n", n_in, out_size, ws_size); grid = -1; return; }
        int dev = 0, cus = 0;
        if (hipGetDevice(&dev) != hipSuccess || hipDeviceGetAttribute(&cus, hipDeviceAttributeMultiprocessorCount, dev) != hipSuccess) { grid = -1; return; }
        if (hipFuncSetAttribute((const void*)mk_fwd, hipFuncAttributeMaxDynamicSharedMemorySize, LDS_BYTES) != hipSuccess) { fprintf(stderr, "kernel_launch: hipFuncSetAttribute failed\n"); grid = -1; return; }
        grid = cus;
    }
    if (grid < 0) return;
    unsigned char* ws = (unsigned char*)d_ws;
    (void)hipMemsetAsync(ws + WS_CTL, 0, CTL_BYTES, stream);
    Args a{};
    for (int i = 0; i < 14; ++i) a.in[i] = (const float*)d_in[i];
    a.out = (float*)d_out; a.ws = ws;
    int li = 0;
#define MK(lo_, hi_) do { a.ph_lo = (lo_); a.ph_hi = (hi_); a.li = li++; hipLaunchKernelGGL(mk_fwd, dim3(grid), dim3(NWAVES * 64), LDS_BYTES, stream, a); } while (0)
    MK(0, N_PHASES);
#undef MK
}
```

```cpp
#include <hip/hip_runtime.h>
#include <cstdio>
#include <cstdint>

typedef unsigned short bf16;
constexpr int S = 16384, D = 1024;
constexpr int EVEN_IN = 3072, ODD_IN = 3336, ODD_PAD = 3584;
constexpr float RMS_EPS = 1e-6f;
constexpr int O_Q = 0, O_K = 512, O_V = 640, O_GC = 768, O_DQ = 1280, O_DK = 1536, O_DV = 1792, O_DO = 2304, O_GD = 2816, O_DI = 3328, O_DF = 3332;
constexpr int SC = 256, NSC = S / SC;

constexpr size_t MiB = 1u << 20;
constexpr size_t WS_CTL = 0;
constexpr size_t CTL_BYTES = 1 * MiB;
constexpr size_t WS_SS0 = 1 * MiB;
constexpr size_t WS_MSC = 1 * MiB + 128 * 1024;
constexpr size_t WS_W1 = 2 * MiB, WS_W2 = 8 * MiB, WS_W3 = 10 * MiB, WS_W4 = 17 * MiB;
constexpr size_t WS_XB = 20 * MiB, WS_YB = 52 * MiB, WS_PB = 84 * MiB, WS_CLOC = 196 * MiB, WS_END = 206 * MiB;
constexpr int CLOC_STRIDE = 64 * 128 + 64;

namespace pg8 {
#define PG8_LAS __attribute__((address_space(3)))
typedef unsigned short bf16_t;
typedef short bf16x8 __attribute__((ext_vector_type(8)));
typedef float f32x4 __attribute__((ext_vector_type(4)));
typedef unsigned u32x4 __attribute__((ext_vector_type(4)));
constexpr int BM = 256, BK = 64, HALF = 128, HTB = HALF * BK * 2  , STAGE_BYTES = 8 * HTB, NXCD = 8, WGM = 8;

__host__ __device__ __forceinline__ int lds_byte(int r, int c) { const int st = (r >> 4) * 2 + (c >> 5), rr = r & 15, cc = c & 31, ob = rr * 64 + cc * 2; return st * 1024 + (ob ^ (((ob >> 9) & 1) << 5)); }
__host__ __device__ __forceinline__ void stage_rc(int b, int& R, int& C) { const int st = b / 1024, sb = b % 1024, swz = sb ^ (((sb >> 9) & 1) << 5); R = (st >> 1) * 16 + swz / 64; C = (st & 1) * 32 + (swz % 64) / 2; }
__host__ __device__ __forceinline__ int perm32(int rho) { const int n = rho >> 4, i = rho & 15; return 8 * (i >> 2) + 4 * n + (i & 3); }

struct Unit { int pm, pn; };
struct Gemm { const bf16_t* A; const bf16_t* Bt; int M, N, K; };

struct StaticOrder {
    int nM, nN, nwg, G, c;
    __host__ __device__ void init(int M, int N, int G_, int c_) { nM = M / BM; nN = N / BM; nwg = nM * nN; G = G_; c = c_; }
    __host__ __device__ bool next(int i, Unit& u) const {
        const long L = (long)i * G + c; if (L >= nwg) return false;
        int wgid = (int)L; { const int q = nwg / NXCD, r = nwg % NXCD, xcd = wgid % NXCD, off = wgid / NXCD; wgid = (xcd < r ? xcd * (q + 1) : r * (q + 1) + (xcd - r) * q) + off; }
        const int nig = WGM * nN, gid = wgid / nig, fm = gid * WGM, gsz = (nM - fm) < WGM ? (nM - fm) : WGM;
        u.pm = fm + ((wgid % nig) % gsz); u.pn = (wgid % nig) / gsz; return true;
    }
    __device__ __forceinline__ void a_ready(const Unit&) const {}
    __device__ __forceinline__ void done(const Unit&) const {}
};

typedef float f32x2_t __attribute__((ext_vector_type(2))); typedef __bf16 bf16x2_t __attribute__((ext_vector_type(2)));
__device__ __forceinline__ unsigned cvt_pk_bf16(float lo, float hi) { f32x2_t v = {lo, hi}; bf16x2_t b = __builtin_convertvector(v, bf16x2_t); return __builtin_bit_cast(unsigned, b); }
struct EpiScaleBf16 {
    static constexpr bool PERM = true, AFTER_DRAIN = false;
    bf16_t* O; int ldc; const float* ss;
    __device__ __forceinline__ void operator()(const f32x4 (&acc)[2][2][4][2], const Unit& u, int wr, int wc, int fr, int fq) const {
        const int row0 = u.pm * BM + wr * 64 + fr, col0 = u.pn * BM + wc * 32 + 8 * fq;
#pragma unroll
        for (int ai = 0; ai < 2; ++ai)
#pragma unroll
            for (int m = 0; m < 4; ++m) { const int row = row0 + ai * HALF + m * 16; const float rs = __builtin_amdgcn_rsqf(ss[row] * (1.0f / 1024.0f) + 1e-6f);
                bf16_t* rowp = O + (size_t)row * ldc + col0;
#pragma unroll
                for (int bj = 0; bj < 2; ++bj) { const f32x4 v0 = acc[ai][bj][m][0] * rs, v1 = acc[ai][bj][m][1] * rs;
                    u32x4 w; w.x = cvt_pk_bf16(v0[0], v0[1]); w.y = cvt_pk_bf16(v0[2], v0[3]); w.z = cvt_pk_bf16(v1[0], v1[1]); w.w = cvt_pk_bf16(v1[2], v1[3]);
                    *(u32x4*)(rowp + bj * HALF) = w; } }
    }
};
struct EpiResid {
    static constexpr bool PERM = false, AFTER_DRAIN = false;
    const bf16_t* base; float* out; bf16_t* xb; float* ss;
    __device__ __forceinline__ void operator()(const f32x4 (&acc)[2][2][4][2], const Unit& u, int wr, int wc, int fr, int fq) const {
        typedef unsigned u32x2v __attribute__((ext_vector_type(2)));
        const int row0 = u.pm * BM + wr * 64 + fr, col0 = u.pn * BM + wc * 32 + 4 * fq;
#pragma unroll
        for (int ai = 0; ai < 2; ++ai)
#pragma unroll
            for (int m = 0; m < 4; ++m) { const int row = row0 + ai * HALF + m * 16; const size_t off = (size_t)row * 1024 + col0; float sq = 0.f;
#pragma unroll
                for (int bj = 0; bj < 2; ++bj)
#pragma unroll
                    for (int n = 0; n < 2; ++n) { const size_t o2 = off + bj * HALF + n * 16; const u32x2v bv = *(const u32x2v*)(base + o2);
                        f32x4 o = acc[ai][bj][m][n]; o[0] += __uint_as_float(bv.x << 16); o[1] += __uint_as_float(bv.x & 0xffff0000u); o[2] += __uint_as_float(bv.y << 16); o[3] += __uint_as_float(bv.y & 0xffff0000u);
                        if (out) *(f32x4*)(out + o2) = o;
                        sq += (o[0] * o[0] + o[1] * o[1]) + (o[2] * o[2] + o[3] * o[3]);
                        if (xb) { u32x2v w; w.x = cvt_pk_bf16(o[0], o[1]); w.y = cvt_pk_bf16(o[2], o[3]); *(u32x2v*)(xb + o2) = w; } }
                sq += __shfl_xor(sq, 16); sq += __shfl_xor(sq, 32);
                if (fq == 0) atomicAdd(ss + row, sq); }
    }
};
template <class Epi, class Sched, bool ALIGN_EPI = false, bool SP2 = false>
__device__ __forceinline__ void gemm_phase(PG8_LAS unsigned char* lds, const Gemm g, const Sched& S, const Epi& E) {
    const int tid = threadIdx.x, wid = __builtin_amdgcn_readfirstlane(tid >> 6), lane = tid & 63, wr = wid >> 2, wc = wid & 3, fr = lane & 15, fq = lane >> 4;
    const int K = g.K, nt = K / BK;
    unsigned voffA[2], voffB[2];
#pragma unroll
    for (int i = 0; i < 2; ++i) { int R, C; stage_rc(tid * 16 + i * 8192, R, C); const int Rb = Epi::PERM ? ((R & ~31) + perm32(R & 31)) : R;
        voffA[i] = (unsigned)(R * K + C) * 2u; voffB[i] = (unsigned)(Rb * K + C) * 2u; }
    const size_t kstep = (size_t)(BK * 2);
    const size_t hstep = (size_t)HALF * K * 2;
    const size_t tstep = 2 * hstep;
    const unsigned ldsw = (unsigned)wid * 1024u;
    const int aoff = lds_byte(wr * 64 + fr, fq * 8), boff = lds_byte(wc * 32 + fr, fq * 8);
#define PG8_SA(b, h) (((b) * 2 + (h)) * HTB)
#define PG8_SB(b, h) ((4 + (b) * 2 + (h)) * HTB)
#define PG8_STAGE(bufoff, gbase, voff) do { _Pragma("unroll") for (int _i = 0; _i < 2; ++_i) \
        __builtin_amdgcn_global_load_lds((const unsigned*)((const char*)(gbase) + (voff)[_i]), (PG8_LAS unsigned*)(lds + (bufoff) + ldsw + _i * 8192), 16, 0, 0); } while (0)
#define PG8_LDA(dst, b, h) do { _Pragma("unroll") for (int m = 0; m < 4; ++m) _Pragma("unroll") for (int k = 0; k < 2; ++k) dst[m][k] = *(const PG8_LAS bf16x8*)(lds + PG8_SA(b, h) + aoff + m * 2048 + k * 1024); } while (0)
#define PG8_LDB(dst, b, h) do { _Pragma("unroll") for (int n = 0; n < 2; ++n) _Pragma("unroll") for (int k = 0; k < 2; ++k) dst[n][k] = *(const PG8_LAS bf16x8*)(lds + PG8_SB(b, h) + boff + n * 2048 + k * 1024); } while (0)
#define PG8_MMA(ai, bj, At, Bt) do { __builtin_amdgcn_s_setprio(1); _Pragma("unroll") for (int m = 0; m < 4; ++m) _Pragma("unroll") for (int n = 0; n < 2; ++n) _Pragma("unroll") for (int k = 0; k < 2; ++k) \
        acc[ai][bj][m][n] = __builtin_amdgcn_mfma_f32_16x16x32_bf16(Bt[n][k], At[m][k], acc[ai][bj][m][n], 0, 0, 0); __builtin_amdgcn_s_setprio(0); } while (0)
#define PG8_WAIT_V(n) asm volatile("s_waitcnt vmcnt(" #n ")" ::: "memory")
#define PG8_WAIT_L(n) asm volatile("s_waitcnt lgkmcnt(" #n ")" ::: "memory")
#define PG8_BAR __builtin_amdgcn_s_barrier()
#define PG8_SCHED __builtin_amdgcn_sched_barrier(0)
    Unit cur, nxt; int ui = 0;
    if (!S.next(0, cur)) return;
    f32x4 acc[2][2][4][2];
#pragma unroll
    for (int a = 0; a < 2; ++a)
#pragma unroll
        for (int b = 0; b < 2; ++b)
#pragma unroll
            for (int m = 0; m < 4; ++m)
#pragma unroll
                for (int n = 0; n < 2; ++n) acc[a][b][m][n] = (f32x4){0.f, 0.f, 0.f, 0.f};
    bf16x8 At[4][2], B0[2][2], B1[2][2];
    const char* cA = (const char*)g.A + (size_t)cur.pm * tstep; const char* cB = (const char*)g.Bt + (size_t)cur.pn * tstep;
    S.a_ready(cur);
    if constexpr (SP2) {
        PG8_STAGE(PG8_SB(0, 0), cB, voffB); PG8_STAGE(PG8_SB(0, 1), cB + hstep, voffB); PG8_STAGE(PG8_SA(0, 0), cA, voffA); PG8_STAGE(PG8_SA(0, 1), cA + hstep, voffA);
        if (wr == 1) PG8_BAR;
        PG8_WAIT_V(2); PG8_BAR;
        PG8_STAGE(PG8_SB(1, 0), cB + kstep, voffB); PG8_STAGE(PG8_SA(1, 0), cA + kstep, voffA); PG8_STAGE(PG8_SB(1, 1), cB + hstep + kstep, voffB);
        PG8_WAIT_V(6); PG8_BAR;
    } else {
        PG8_STAGE(PG8_SB(0, 0), cB, voffB); PG8_STAGE(PG8_SA(0, 0), cA, voffA); PG8_STAGE(PG8_SB(0, 1), cB + hstep, voffB); PG8_STAGE(PG8_SA(0, 1), cA + hstep, voffA);
        if (wr == 1) PG8_BAR;
        PG8_WAIT_V(4); PG8_BAR;
        PG8_STAGE(PG8_SB(1, 0), cB + kstep, voffB); PG8_STAGE(PG8_SA(1, 0), cA + kstep, voffA); PG8_STAGE(PG8_SB(1, 1), cB + hstep + kstep, voffB);
        PG8_WAIT_V(6); PG8_BAR;
    }
    for (;;) {
        const bool has_next = S.next(ui + 1, nxt);
        const char* nA = has_next ? (const char*)g.A + (size_t)nxt.pm * tstep : cA; const char* nB = has_next ? (const char*)g.Bt + (size_t)nxt.pn * tstep : cB;
        for (int t = 0; t < nt; t += 2) {
            const bool last = (t == nt - 2);
            const char* a1 = cA + (size_t)(t + 1) * kstep;
            const char* a2 = last ? nA : cA + (size_t)(t + 2) * kstep; const char* b2 = last ? nB : cB + (size_t)(t + 2) * kstep;
            const char* a3 = a2 + kstep; const char* b3 = b2 + kstep;
            if (last && has_next) S.a_ready(nxt);
            if constexpr (SP2) {
            PG8_LDB(B0, 0, 0); PG8_LDB(B1, 0, 1); PG8_SCHED; PG8_LDA(At, 0, 0); PG8_STAGE(PG8_SA(1, 1), a1 + hstep, voffA);
            PG8_WAIT_V(8); PG8_WAIT_L(0); PG8_BAR; PG8_MMA(0, 0, At, B0); PG8_MMA(0, 1, At, B1); PG8_BAR; PG8_SCHED;
            PG8_LDA(At, 0, 1); PG8_STAGE(PG8_SB(0, 0), b2, voffB); PG8_STAGE(PG8_SB(0, 1), b2 + hstep, voffB); PG8_STAGE(PG8_SA(0, 0), a2, voffA);
            PG8_WAIT_V(8); PG8_WAIT_L(0); PG8_BAR; PG8_MMA(1, 0, At, B0); PG8_MMA(1, 1, At, B1); PG8_BAR; PG8_SCHED;
            PG8_LDB(B0, 1, 0); PG8_LDB(B1, 1, 1); PG8_SCHED; PG8_LDA(At, 1, 0); PG8_STAGE(PG8_SA(0, 1), a2 + hstep, voffA);
            PG8_WAIT_V(8); PG8_WAIT_L(0); PG8_BAR; PG8_MMA(0, 0, At, B0); PG8_MMA(0, 1, At, B1); PG8_BAR; PG8_SCHED;
            PG8_LDA(At, 1, 1); PG8_STAGE(PG8_SB(1, 0), b3, voffB); PG8_STAGE(PG8_SB(1, 1), b3 + hstep, voffB); PG8_STAGE(PG8_SA(1, 0), a3, voffA);
            PG8_WAIT_V(8); PG8_WAIT_L(0); PG8_BAR; PG8_MMA(1, 0, At, B0); PG8_MMA(1, 1, At, B1); PG8_BAR; PG8_SCHED;
            } else {
            PG8_LDB(B0, 0, 0); PG8_SCHED; PG8_LDA(At, 0, 0); PG8_STAGE(PG8_SA(1, 1), a1 + hstep, voffA);
            PG8_WAIT_L(8); PG8_BAR; PG8_WAIT_L(0); PG8_MMA(0, 0, At, B0); PG8_BAR; PG8_SCHED;
            PG8_LDB(B1, 0, 1); PG8_STAGE(PG8_SB(0, 0), b2, voffB);
            PG8_BAR; PG8_WAIT_L(0); PG8_MMA(0, 1, At, B1); PG8_BAR;
            PG8_LDA(At, 0, 1); PG8_STAGE(PG8_SA(0, 0), a2, voffA);
            PG8_BAR; PG8_WAIT_L(0); PG8_MMA(1, 0, At, B0); PG8_BAR; PG8_SCHED;
            PG8_STAGE(PG8_SB(0, 1), b2 + hstep, voffB);
            PG8_WAIT_V(6); PG8_BAR; PG8_MMA(1, 1, At, B1); PG8_BAR;
            PG8_LDB(B0, 1, 0); PG8_SCHED; PG8_LDA(At, 1, 0); PG8_STAGE(PG8_SA(0, 1), a2 + hstep, voffA);
            PG8_WAIT_L(8); PG8_BAR; PG8_WAIT_L(0); PG8_MMA(0, 0, At, B0); PG8_BAR; PG8_SCHED;
            PG8_LDB(B1, 1, 1); PG8_STAGE(PG8_SB(1, 0), b3, voffB);
            PG8_BAR; PG8_WAIT_L(0); PG8_MMA(0, 1, At, B1); PG8_BAR;
            PG8_LDA(At, 1, 1); PG8_STAGE(PG8_SA(1, 0), a3, voffA);
            PG8_BAR; PG8_WAIT_L(0); PG8_MMA(1, 0, At, B0); PG8_BAR; PG8_SCHED;
            PG8_STAGE(PG8_SB(1, 1), b3 + hstep, voffB);
            PG8_WAIT_V(6); PG8_BAR; PG8_MMA(1, 1, At, B1); PG8_BAR;
            }
        }
        if constexpr (ALIGN_EPI) { if (wr == 0) PG8_BAR; }
        if constexpr (!Epi::AFTER_DRAIN) { E(acc, cur, wr, wc, fr, fq); S.done(cur); }
        if (!has_next) break;
#pragma unroll
        for (int a = 0; a < 2; ++a)
#pragma unroll
            for (int b = 0; b < 2; ++b)
#pragma unroll
                for (int m = 0; m < 4; ++m)
#pragma unroll
                    for (int n = 0; n < 2; ++n) acc[a][b][m][n] = (f32x4){0.f, 0.f, 0.f, 0.f};
        cur = nxt; cA = nA; cB = nB; ++ui;
        if constexpr (ALIGN_EPI) { if (wr == 1) PG8_BAR; }
    }
    PG8_WAIT_V(0);
    if constexpr (!ALIGN_EPI) { if (wr == 0) PG8_BAR; }
    PG8_BAR;
    if constexpr (Epi::AFTER_DRAIN) { E.fused(acc, cur, wr, wc, fr, fq, lds, wid, lane); S.done(cur); }
#undef PG8_SA
#undef PG8_SB
#undef PG8_STAGE
#undef PG8_LDA
#undef PG8_LDB
#undef PG8_MMA
#undef PG8_WAIT_V
#undef PG8_WAIT_L
#undef PG8_BAR
#undef PG8_SCHED
}
}

#ifndef PG8_SP2
#define PG8_SP2 true
#endif
#ifndef PG8_ALIGN
#define PG8_ALIGN true
#endif
#define GAS __attribute__((address_space(1)))
#define LAS __attribute__((address_space(3)))
typedef unsigned short bf16;
typedef unsigned v4u __attribute__((ext_vector_type(4)));
typedef float f32x4 __attribute__((ext_vector_type(4)));
typedef short bf16x8 __attribute__((ext_vector_type(8)));
typedef GAS unsigned gu32;
typedef GAS unsigned long long gu64;
#define RLX_AGENT __ATOMIC_RELAXED, __HIP_MEMORY_SCOPE_AGENT
#define LDS_WAIT() asm volatile("s_waitcnt lgkmcnt(0)" ::: "memory")
#define VM_WAIT() asm volatile("s_waitcnt vmcnt(0)" ::: "memory")
__device__ __forceinline__ unsigned long long rt() { return __builtin_amdgcn_s_memrealtime(); }
__device__ __forceinline__ unsigned f2bf(float f) { unsigned u = __builtin_bit_cast(unsigned, f); return (u + 0x7fffu + ((u >> 16) & 1u)) >> 16; }
__device__ __forceinline__ unsigned pk2(float lo, float hi) { return f2bf(lo) | (f2bf(hi) << 16); }

#define XB_TMO      128
#define XB_XCNT(j)  (256  + 64 * (j))
#define XB_XSUB(j)  (1280 + 64 * (j))
#define XB_XGEN(j)  (2304 + 64 * (j))
#define XB_TOP      3328
#define XB_TOPGEN   3392
#define XCD_BAR_WORDS 3456
#define XB_SPIN_CAP (1u << 18)

__device__ __forceinline__ unsigned xb_ld(unsigned* p)              { return __hip_atomic_load(p, __ATOMIC_RELAXED, __HIP_MEMORY_SCOPE_AGENT); }
__device__ __forceinline__ unsigned xb_add(unsigned* p, unsigned v) { return __hip_atomic_fetch_add(p, v, __ATOMIC_RELAXED, __HIP_MEMORY_SCOPE_AGENT); }
__device__ __forceinline__ unsigned xb_xcc_id() { return (unsigned)__builtin_amdgcn_s_getreg((3 << 11) | 20) & 0xFu; }
#define XB_SPIN(cond, bar) do { unsigned _sp = 0; while (cond) { __builtin_amdgcn_s_sleep(1); \
    if ((++_sp & 255u) == 0u) { if (xb_ld(&(bar)[XB_TMO])) break; if (_sp > XB_SPIN_CAP) { atomicAdd(&(bar)[XB_TMO], 1u); break; } } } } while (0)

struct XcdBarrier {
    unsigned* bar; unsigned x;
    volatile LAS unsigned* st;
};

__device__ __forceinline__ XcdBarrier xcd_barrier_post(unsigned* bar, volatile LAS unsigned* st) {
    XcdBarrier b; b.bar = bar; b.x = xb_xcc_id(); b.st = st;
    if (threadIdx.x == 0) (void)xb_add(&bar[XB_XCNT(b.x)], 1u);
    return b;
}
__device__ __forceinline__ void xcd_barrier_complete(unsigned* bar, unsigned x, unsigned& nloc, unsigned& nx) {
    const unsigned G = gridDim.x * gridDim.y * gridDim.z;
    unsigned sum, cnt, mine, sp = 0u;
    for (;;) {
        sum = 0u; cnt = 0u; mine = 0u;
#pragma unroll
        for (unsigned j = 0; j < 16; ++j) { const unsigned c = xb_ld(&bar[XB_XCNT(j)]); sum += c; cnt += (c > 0u) ? 1u : 0u; mine = (j == x) ? c : mine; }
        if (sum == G) break;
        __builtin_amdgcn_s_sleep(1);
        if ((++sp & 255u) == 0u) { if (xb_ld(&bar[XB_TMO])) break; if (sp > XB_SPIN_CAP) { atomicAdd(&bar[XB_TMO], 1u); break; } }
    }
    nloc = mine > 0u ? mine : 1u; nx = cnt > 0u ? cnt : 1u;
}

__device__ __forceinline__ void xcd_barrier(const XcdBarrier& b) {
    asm volatile("s_waitcnt vmcnt(0)" ::: "memory");
    __syncthreads();
    if (threadIdx.x == 0) {
        unsigned* bar = b.bar;
        __builtin_amdgcn_s_waitcnt(0);
        unsigned nloc = b.st[0], nx = b.st[1];
        if (nloc == 0u) { xcd_barrier_complete(bar, b.x, nloc, nx); b.st[0] = nloc; b.st[1] = nx; }
        const unsigned old = xb_add(&bar[XB_XSUB(b.x)], 1u);
        const unsigned gen = old / nloc;
        if (old + 1u == (gen + 1u) * nloc) {
            __builtin_amdgcn_fence(__ATOMIC_RELEASE, "agent");
            asm volatile("s_waitcnt vmcnt(0)" ::: "memory");
            const unsigned og = xb_add(&bar[XB_TOP], 1u);
            const unsigned tg = og / nx;
            if (og + 1u == (tg + 1u) * nx) xb_add(&bar[XB_TOPGEN], 1u);
            else XB_SPIN(xb_ld(&bar[XB_TOPGEN]) == tg, bar);
            __builtin_amdgcn_fence(__ATOMIC_ACQUIRE, "agent");
            xb_add(&bar[XB_XGEN(b.x)], 1u);
            asm volatile("s_waitcnt vmcnt(0)" ::: "memory");
        } else {
            XB_SPIN(xb_ld(&bar[XB_XGEN(b.x)]) == gen, bar);
            __builtin_amdgcn_fence(__ATOMIC_ACQUIRE, "agent");
            asm volatile("s_waitcnt vmcnt(0)" ::: "memory");
        }
    }
    __syncthreads();
}

__device__ __forceinline__ float bf2f(bf16 v) { return __uint_as_float((unsigned)v << 16); }
__device__ __forceinline__ float silu_f(float x) { return x / (1.f + __expf(-x)); }
__device__ __forceinline__ float sigmoid_f(float x) { return 1.f / (1.f + __expf(-x)); }
__device__ __forceinline__ float logsig_f(float x) { return fminf(x, 0.f) - log1pf(__expf(-fabsf(x))); }
struct WPrep { const float *e_norm, *e_win, *e_pw, *e_ps, *e_wout, *o_norm, *o_win, *o_wout; bf16 *w1, *w2, *w3, *w4; };
__device__ __forceinline__ float wsrc(const WPrep& P, int mat, int k, int n) {
    if (mat == 0) return P.e_norm[k] * P.e_win[(size_t)k * EVEN_IN + n];
    if (mat == 1) return P.e_wout[(size_t)k * D + n];
    if (mat == 2) { int o = n < 2304 ? n : (n < 3328 ? n + 8 : (n < 3336 ? n - 1024 : -1)); return o < 0 ? 0.f : P.o_norm[k] * P.o_win[(size_t)k * ODD_IN + o]; }
    return P.o_wout[(size_t)k * D + n];
}
__device__ __forceinline__ void wprep_item(const WPrep& P, int mat, int kb, int nb, float* scr, int lane) {
    const int k0 = 64 * kb, n0 = 32 * nb;
    bf16* WT = mat == 0 ? P.w1 : mat == 1 ? P.w2 : mat == 2 ? P.w3 : P.w4;
    {
#pragma unroll 8
        for (int i = 0; i < 32; ++i) { const int kk = 2 * i + (lane >> 5); scr[kk * 33 + (lane & 31)] = wsrc(P, mat, k0 + kk, n0 + (lane & 31)); }
    }
    __builtin_amdgcn_s_waitcnt(0xc07f); __builtin_amdgcn_wave_barrier();
    const int c = lane & 7;
#pragma unroll
    for (int j = 0; j < 4; ++j) { const int n = (lane >> 3) + 8 * j; const float* s = scr + (8 * c) * 33 + n;
        uint4 o; o.x = f2bf(s[0]) | ((unsigned)f2bf(s[33]) << 16); o.y = f2bf(s[66]) | ((unsigned)f2bf(s[99]) << 16);
        o.z = f2bf(s[132]) | ((unsigned)f2bf(s[165]) << 16); o.w = f2bf(s[198]) | ((unsigned)f2bf(s[231]) << 16);
        *(uint4*)(WT + (size_t)(n0 + n) * D + k0 + 8 * c) = o; }
    __builtin_amdgcn_s_waitcnt(0xc07f); __builtin_amdgcn_wave_barrier();
}
__device__ __forceinline__ void wprep_pool_item(const WPrep& P, int kb, int nbp, float* Ls, int tid, int lane, int wave) {
    const int k0 = 64 * kb, cc0 = 32 * nbp, grp = cc0 >> 7, c0 = cc0 & 127;
    float* Pw = Ls; float* Wt = Ls + 4096; float* Ot = Wt + 64 * 129;
#pragma unroll
    for (int i = 0; i < 8; ++i) { const int idx = tid + 512 * i; Pw[idx] = P.e_pw[(size_t)grp * 16384 + (idx >> 5) * 128 + c0 + (idx & 31)]; }
#pragma unroll
    for (int i = 0; i < 16; ++i) { const int idx = tid + 512 * i, k = idx >> 7, c = idx & 127; Wt[k * 129 + c] = P.e_win[(size_t)(k0 + k) * EVEN_IN + 2048 + 128 * grp + c]; }
    __syncthreads();
    { const int k = tid >> 3, n4 = (tid & 7) * 4; float a0 = 0.f, a1 = 0.f, a2 = 0.f, a3 = 0.f;
#pragma unroll 8
        for (int c = 0; c < 128; ++c) { const float a = Wt[k * 129 + c]; const float4 b = *(const float4*)(Pw + c * 32 + n4); a0 += a * b.x; a1 += a * b.y; a2 += a * b.z; a3 += a * b.w; }
        const float g = P.e_norm[k0 + k]; const float4 ps = *(const float4*)(P.e_ps + cc0 + n4);
        Ot[k * 33 + n4] = a0 * g * ps.x; Ot[k * 33 + n4 + 1] = a1 * g * ps.y; Ot[k * 33 + n4 + 2] = a2 * g * ps.z; Ot[k * 33 + n4 + 3] = a3 * g * ps.w; }
    __syncthreads();
    if (wave == 0) { const int c = lane & 7;
#pragma unroll
        for (int j = 0; j < 4; ++j) { const int n = (lane >> 3) + 8 * j; const float* s = Ot + (8 * c) * 33 + n;
            uint4 o; o.x = f2bf(s[0]) | ((unsigned)f2bf(s[33]) << 16); o.y = f2bf(s[66]) | ((unsigned)f2bf(s[99]) << 16);
            o.z = f2bf(s[132]) | ((unsigned)f2bf(s[165]) << 16); o.w = f2bf(s[198]) | ((unsigned)f2bf(s[231]) << 16);
            *(uint4*)(P.w1 + (size_t)(2048 + cc0 + n) * D + k0 + 8 * c) = o; } }
    __syncthreads();
}
constexpr int WI_0 = 16 * (3072 / 32), WI_1 = 16 * 32, WI_2 = 16 * (3584 / 32), WI_3 = 16 * 32, WI_ALL = WI_0 + WI_1 + WI_2 + WI_3;
constexpr int RING_OFF = 0, RING_BYTES = 131072;
constexpr int LDSCTL_OFF = RING_BYTES, MISC_OFF = LDSCTL_OFF + 320;
constexpr int LDS_BYTES = 147456;
constexpr int NWAVES = 8;
constexpr int CW_BAR = 4096;
constexpr int N_PHASES = 9;
constexpr int DUP = -1;
#define REPS(k) for (int rep = 0; rep < ((DUP == (k)) ? 2 : 1); ++rep)

__device__ __forceinline__ void prep_x_row(const float* __restrict__ x, bf16* __restrict__ xb, float* __restrict__ ss, int row, int lane) {
    const float4* xr = (const float4*)(x + (size_t)row * D) + lane; float s = 0.f;
    uint2* o = (uint2*)(xb + (size_t)row * D) + lane;
#pragma unroll
    for (int j = 0; j < 4; ++j) { const float4 v = xr[64 * j]; s += v.x * v.x + v.y * v.y + v.z * v.z + v.w * v.w;
        uint2 w; w.x = pg8::cvt_pk_bf16(v.x, v.y); w.y = pg8::cvt_pk_bf16(v.z, v.w); o[64 * j] = w; }
#pragma unroll
    for (int m = 1; m < 64; m <<= 1) s += __shfl_xor(s, m);
    if (lane == 0) ss[row] = s;
}
__device__ __forceinline__ void final_row(const float* src, float* dst, const float* __restrict__ ss, const float* __restrict__ g, int row, int lane) {
    const float4* xr = (const float4*)(src + (size_t)row * D) + lane; float4* xw = (float4*)(dst + (size_t)row * D) + lane; const float rs = rsqrtf(ss[row] * (1.f / D) + RMS_EPS);
#pragma unroll
    for (int j = 0; j < 4; ++j) { float4 v = xr[64 * j]; const float4 gv = ((const float4*)g)[lane + 64 * j];
        v.x *= rs * gv.x; v.y *= rs * gv.y; v.z *= rs * gv.z; v.w *= rs * gv.w; xw[64 * j] = v; }
}
__device__ __forceinline__ void unpack8(const uint4 v, float (&f)[8]) {
    f[0] = __uint_as_float(v.x << 16); f[1] = __uint_as_float(v.x & 0xffff0000u); f[2] = __uint_as_float(v.y << 16); f[3] = __uint_as_float(v.y & 0xffff0000u);
    f[4] = __uint_as_float(v.z << 16); f[5] = __uint_as_float(v.z & 0xffff0000u); f[6] = __uint_as_float(v.w << 16); f[7] = __uint_as_float(v.w & 0xffff0000u);
}
__device__ __forceinline__ uint4 pack8(const float (&f)[8]) { uint4 o; o.x = pg8::cvt_pk_bf16(f[0], f[1]); o.y = pg8::cvt_pk_bf16(f[2], f[3]); o.z = pg8::cvt_pk_bf16(f[4], f[5]); o.w = pg8::cvt_pk_bf16(f[6], f[7]); return o; }
constexpr int EM_RUN = 16;
__device__ __forceinline__ void even_mix_unit(const bf16* __restrict__ PB, const float* __restrict__ cw, bf16* __restrict__ YB, int unit, int lane) {
    const int half = unit & 1, t0 = (unit >> 1) * EM_RUN, c8 = lane * 8;
    if (half == 0) {
        const bf16* p = PB + (size_t)t0 * EVEN_IN + c8;
        float w0[8], w1[8], w2[8], u1[8], u2[8];
#pragma unroll
        for (int i = 0; i < 8; ++i) { w0[i] = cw[c8 + i]; w1[i] = cw[512 + c8 + i]; w2[i] = cw[1024 + c8 + i]; u1[i] = 0.f; u2[i] = 0.f; }
        if (t0 > 0) { float a[8], b[8];
            unpack8(*(const uint4*)(p - 2 * EVEN_IN), a); unpack8(*(const uint4*)(p - 2 * EVEN_IN + 1024), b);
#pragma unroll
            for (int i = 0; i < 8; ++i) u2[i] = a[i] * b[i];
            unpack8(*(const uint4*)(p - EVEN_IN), a); unpack8(*(const uint4*)(p - EVEN_IN + 1024), b);
#pragma unroll
            for (int i = 0; i < 8; ++i) u1[i] = a[i] * b[i]; }
#pragma unroll 4
        for (int t = 0; t < EM_RUN; ++t) { const bf16* q = p + (size_t)t * EVEN_IN; float xa[8], bg[8], cg[8], ga[8], y[8];
            unpack8(*(const uint4*)q, xa); unpack8(*(const uint4*)(q + 512), bg); unpack8(*(const uint4*)(q + 1024), cg); unpack8(*(const uint4*)(q + 1536), ga);
#pragma unroll
            for (int i = 0; i < 8; ++i) { const float u0 = cg[i] * xa[i]; y[i] = bg[i] * (w0[i] * u2[i] + w1[i] * u1[i] + w2[i] * u0) * silu_f(ga[i]); u2[i] = u1[i]; u1[i] = u0; }
            *(uint4*)(YB + (size_t)(t0 + t) * D + c8) = pack8(y); }
    } else {
        const int w = 2 << (lane >> 4); const bf16* p = PB + (size_t)t0 * EVEN_IN + 2048 + c8; float sum[8];
#pragma unroll
        for (int i = 0; i < 8; ++i) sum[i] = 0.f;
        for (int j = 1; j < 16; ++j) if (j < w && t0 - j >= 0) { float a[8]; unpack8(*(const uint4*)(p - j * EVEN_IN), a);
#pragma unroll
            for (int i = 0; i < 8; ++i) sum[i] += a[i]; }
#pragma unroll 4
        for (int t = 0; t < EM_RUN; ++t) { const bf16* q = p + (size_t)t * EVEN_IN; float u[8], gb[8], old[8], y[8]; const int tt = t0 + t, tb = tt - (w - 1);
            unpack8(*(const uint4*)q, u); unpack8(*(const uint4*)(q + 512), gb);
            if (tb >= 0) unpack8(*(const uint4*)(q - (w - 1) * EVEN_IN), old); else {
#pragma unroll
                for (int i = 0; i < 8; ++i) old[i] = 0.f; }
            const float inv = 1.f / (float)(tt + 1 < w ? tt + 1 : w);
#pragma unroll
            for (int i = 0; i < 8; ++i) { sum[i] += u[i]; y[i] = (sum[i] * inv - u[i]) * silu_f(gb[i]); sum[i] -= old[i]; }
            *(uint4*)(YB + (size_t)tt * D + 512 + c8) = pack8(y); }
    }
}

typedef float f32x16 __attribute__((ext_vector_type(16)));
typedef unsigned u32x2 __attribute__((ext_vector_type(2)));
#define MFMA32(a, b, c) __builtin_amdgcn_mfma_f32_32x32x16_bf16((a), (b), (c), 0, 0, 0)
__device__ __forceinline__ int crow(int i, int h) { return (i & 3) + 8 * (i >> 2) + 4 * h; }
__device__ __forceinline__ bf16x8 pack8_acc(const f32x16& x, int s) {
    pg8::u32x4 p; p.x = pg8::cvt_pk_bf16(x[8 * s], x[8 * s + 1]); p.y = pg8::cvt_pk_bf16(x[8 * s + 2], x[8 * s + 3]); p.z = pg8::cvt_pk_bf16(x[8 * s + 4], x[8 * s + 5]); p.w = pg8::cvt_pk_bf16(x[8 * s + 6], x[8 * s + 7]);
    return __builtin_bit_cast(bf16x8, p);
}
constexpr int AT_KP = 144, AT_VP = 520, AT_K_OFF = 0, AT_V_OFF = 256 * AT_KP, AT_END = AT_V_OFF + 64 * AT_VP;
static_assert(AT_END <= RING_BYTES, "attention LDS");
__device__ __forceinline__ void attn_unit(LAS unsigned char* L, const bf16* __restrict__ PB, const float* __restrict__ sinks, bf16* __restrict__ YB, int nb, int g, int tid, int lane, int wave) {
    const int tokb = (nb - 1) * 128;
#pragma unroll
    for (int i = 0; i < 4; ++i) { const int c = tid + 512 * i, row = c >> 3, ch = c & 7, tok = tokb + row; uint4 v = {0u, 0u, 0u, 0u};
        if (tok >= 0) v = *(const uint4*)(PB + (size_t)tok * ODD_PAD + O_K + g * 64 + ch * 8);
        *(LAS pg8::u32x4*)(L + AT_K_OFF + row * AT_KP + ch * 16) = (pg8::u32x4){v.x, v.y, v.z, v.w}; }
#pragma unroll
    for (int i = 0; i < 2; ++i) { const int kp = tid & 127, ch = (tid >> 7) + 4 * i, tok = tokb + 2 * kp; uint4 v0 = {0u, 0u, 0u, 0u}, v1 = {0u, 0u, 0u, 0u};
        if (tok >= 0) { const bf16* src = PB + (size_t)tok * ODD_PAD + O_V + g * 64 + ch * 8; v0 = *(const uint4*)src; v1 = *(const uint4*)(src + ODD_PAD); }
        const unsigned a[4] = {v0.x, v0.y, v0.z, v0.w}, b[4] = {v1.x, v1.y, v1.z, v1.w};
#pragma unroll
        for (int e = 0; e < 4; ++e) { LAS unsigned char* dst = L + AT_V_OFF + (ch * 8 + 2 * e) * AT_VP + kp * 4;
            *(LAS unsigned*)dst = (a[e] & 0xffffu) | (b[e] << 16); *(LAS unsigned*)(dst + AT_VP) = (a[e] >> 16) | (b[e] & 0xffff0000u); } }
    __syncthreads();
    const int hq = 4 * g + (wave >> 1), rh = wave & 1, c = lane & 31, h = lane >> 5;
    const float slope = exp2f(-(float)(hq + 1)), sink = sinks[hq];
#pragma unroll 1
    for (int j = 0; j < 2; ++j) {
        const int q0 = 64 * rh + 32 * j, kt0 = q0 >> 5, t = nb * 128 + q0 + c;
        bf16x8 qf[4];
#pragma unroll
        for (int ks = 0; ks < 4; ++ks) qf[ks] = *(const bf16x8*)(PB + (size_t)t * ODD_PAD + O_Q + hq * 64 + 16 * ks + 8 * h);
        f32x16 p[5];
#pragma unroll
        for (int kk = 0; kk < 5; ++kk) { f32x16 acc;
#pragma unroll
            for (int i = 0; i < 16; ++i) acc[i] = 0.f;
            const LAS unsigned char* kp = L + AT_K_OFF + (32 * (kt0 + kk) + c) * AT_KP + 16 * h;
#pragma unroll
            for (int ks = 0; ks < 4; ++ks) acc = MFMA32(*(const LAS bf16x8*)(kp + 32 * ks), qf[ks], acc);
            p[kk] = acc; __builtin_amdgcn_sched_barrier(0); }
        int cbh = c + 128 - 4 * h; asm volatile("" : "+v"(cbh));
        const int tq = q0 + c; const unsigned lim = nb > 0 ? 127u : (unsigned)tq;
        const float base = -slope * (float)cbh; float mx = sink;
#pragma unroll
        for (int kk = 0; kk < 5; ++kk)
#pragma unroll
            for (int i = 0; i < 16; ++i) { const int kc = 32 * kk + (i & 3) + 8 * (i >> 2); const unsigned dist = (unsigned)(cbh - kc);
                const float s = dist <= lim ? fmaf(slope, (float)kc, fmaf(p[kk][i], 0.125f, base)) : -1e30f; p[kk][i] = s; mx = fmaxf(mx, s); }
        mx = fmaxf(mx, __shfl_xor(mx, 32));
        float l = 0.f;
#pragma unroll
        for (int kk = 0; kk < 5; ++kk)
#pragma unroll
            for (int i = 0; i < 16; ++i) { const float e = __expf(p[kk][i] - mx); p[kk][i] = e; l += e; }
        l += __shfl_xor(l, 32); l += __expf(sink - mx);
        f32x16 o[2];
#pragma unroll
        for (int i = 0; i < 16; ++i) { o[0][i] = 0.f; o[1][i] = 0.f; }
#pragma unroll
        for (int kk = 0; kk < 5; ++kk)
#pragma unroll
            for (int s = 0; s < 2; ++s) { const bf16x8 pb = pack8_acc(p[kk], s); const int kb = 32 * (kt0 + kk) + 16 * s + 4 * h;
#pragma unroll
                for (int dt = 0; dt < 2; ++dt) { const LAS unsigned char* vp = L + AT_V_OFF + (32 * dt + c) * AT_VP + kb * 2;
                    const u32x2 lo = *(const LAS u32x2*)vp, hi = *(const LAS u32x2*)(vp + 16); const pg8::u32x4 av = {lo.x, lo.y, hi.x, hi.y};
                    o[dt] = MFMA32(__builtin_bit_cast(bf16x8, av), pb, o[dt]); }
                __builtin_amdgcn_sched_barrier(0); }
        const float il = 1.f / l; const bf16* grow = PB + (size_t)t * ODD_PAD + O_GC + hq * 64; bf16* yrow = YB + (size_t)t * D + hq * 64;
#pragma unroll
        for (int dt = 0; dt < 2; ++dt)
#pragma unroll
            for (int iq = 0; iq < 4; ++iq) { const int d = 32 * dt + 8 * iq + 4 * h; const uint2 gv = *(const uint2*)(grow + d);
                const float g0 = __uint_as_float(gv.x << 16), g1 = __uint_as_float(gv.x & 0xffff0000u), g2 = __uint_as_float(gv.y << 16), g3 = __uint_as_float(gv.y & 0xffff0000u);
                uint2 w; w.x = pg8::cvt_pk_bf16(o[dt][4 * iq] * il * silu_f(g0), o[dt][4 * iq + 1] * il * silu_f(g1)); w.y = pg8::cvt_pk_bf16(o[dt][4 * iq + 2] * il * silu_f(g2), o[dt][4 * iq + 3] * il * silu_f(g3));
                *(uint2*)(yrow + d) = w; }
    }
    __syncthreads();
}

__device__ __forceinline__ float scan256_add(float v, LAS float* tmp, int lane, int wave) {
#pragma unroll
    for (int d = 1; d < 64; d <<= 1) { const float u = __shfl_up(v, d); if (lane >= d) v += u; }
    if (wave < 4 && lane == 63) tmp[wave] = v;
    __syncthreads();
    float off = 0.f;
#pragma unroll
    for (int w2 = 0; w2 < 3; ++w2) if (w2 < wave) off += tmp[w2];
    __syncthreads();
    return v + off;
}
__device__ __forceinline__ float scan256_max(float v, LAS float* tmp, int lane, int wave) {
#pragma unroll
    for (int d = 1; d < 64; d <<= 1) { const float u = __shfl_up(v, d); if (lane >= d) v = fmaxf(v, u); }
    if (wave < 4 && lane == 63) tmp[wave] = v;
    __syncthreads();
    float off = -INFINITY;
#pragma unroll
    for (int w2 = 0; w2 < 3; ++w2) if (w2 < wave) off = fmaxf(off, tmp[w2]);
    __syncthreads();
    return fmaxf(v, off);
}
template <int NCH_PER_THREAD> __device__ __forceinline__ void stage_transposed(LAS unsigned char* img, int pitch, const bf16* __restrict__ src, int tid) {
#pragma unroll
    for (int i = 0; i < NCH_PER_THREAD; ++i) { const int kp = tid & 127, ch = (tid >> 7) + 4 * i; const bf16* s = src + (size_t)(2 * kp) * ODD_PAD + ch * 8;
        const uint4 v0 = *(const uint4*)s, v1 = *(const uint4*)(s + ODD_PAD); const unsigned a[4] = {v0.x, v0.y, v0.z, v0.w}, b[4] = {v1.x, v1.y, v1.z, v1.w};
#pragma unroll
        for (int e = 0; e < 4; ++e) { LAS unsigned char* dst = img + (ch * 8 + 2 * e) * pitch + kp * 4;
            *(LAS unsigned*)dst = (a[e] & 0xffffu) | (b[e] << 16); *(LAS unsigned*)(dst + pitch) = (a[e] >> 16) | (b[e] & 0xffff0000u); } }
}
constexpr int MA_P = 528, MA_K_OFF = 0, MA_V_OFF = 64 * MA_P, MA_W_OFF = MA_V_OFF + 128 * MA_P, MA_TMP = MA_W_OFF + 1024, MA_END = MA_TMP + 64;
static_assert(MA_END <= RING_BYTES, "mLSTM phase A LDS");
__device__ __forceinline__ void mlstm_a_unit(LAS unsigned char* L, const bf16* __restrict__ PB, const float* __restrict__ ibp, const float* __restrict__ fbp, float* __restrict__ cloc, float* __restrict__ msc, int sc, int hh, int tid, int lane, int wave) {
    const bf16* base = PB + (size_t)sc * SC * ODD_PAD;
    LAS float* wS = (LAS float*)(L + MA_W_OFF); LAS float* tmp = (LAS float*)(L + MA_TMP);
    float lf = 0.f, ipre = 0.f;
    if (tid < 256) { const bf16* r = base + (size_t)tid * ODD_PAD; lf = logsig_f(bf2f(r[O_DF + hh]) + fbp[hh]); ipre = bf2f(r[O_DI + hh]) + ibp[hh]; }
    const float bl = scan256_add(lf, tmp, lane, wave), al = tid < 256 ? ipre - bl : -INFINITY;
    float am = al;
#pragma unroll
    for (int m = 1; m < 64; m <<= 1) am = fmaxf(am, __shfl_xor(am, m));
    if (lane == 0) tmp[wave] = am;
    __syncthreads();
    am = fmaxf(fmaxf(tmp[0], tmp[1]), fmaxf(tmp[2], tmp[3]));
    if (tid < 256) wS[tid] = __expf(al - am);
    if (tid == 255) msc[(sc * 4 + hh) * 2] = bl;
    if (tid == 0) msc[(sc * 4 + hh) * 2 + 1] = am;
    __syncthreads();
#pragma unroll
    for (int i = 0; i < 2; ++i) { const int kp = tid & 127, ch = (tid >> 7) + 4 * i; const bf16* s = base + (size_t)(2 * kp) * ODD_PAD + O_DK + hh * 64 + ch * 8;
        const uint4 v0 = *(const uint4*)s, v1 = *(const uint4*)(s + ODD_PAD); const unsigned a[4] = {v0.x, v0.y, v0.z, v0.w}, b[4] = {v1.x, v1.y, v1.z, v1.w}; const float w0 = wS[2 * kp], w1 = wS[2 * kp + 1];
#pragma unroll
        for (int e = 0; e < 4; ++e) { LAS unsigned char* dst = L + MA_K_OFF + (ch * 8 + 2 * e) * MA_P + kp * 4;
            *(LAS unsigned*)dst = pg8::cvt_pk_bf16(w0 * __uint_as_float(a[e] << 16), w1 * __uint_as_float(b[e] << 16));
            *(LAS unsigned*)(dst + MA_P) = pg8::cvt_pk_bf16(w0 * __uint_as_float(a[e] & 0xffff0000u), w1 * __uint_as_float(b[e] & 0xffff0000u)); } }
    stage_transposed<4>(L + MA_V_OFF, MA_P, base + O_DV + hh * 128, tid);
    __syncthreads();
    const int mt = wave >> 2, nt = wave & 3, c = lane & 31, h2 = lane >> 5;
    f32x16 acc, accn;
#pragma unroll
    for (int i = 0; i < 16; ++i) { acc[i] = 0.f; accn[i] = 0.f; }
    const LAS unsigned char* ap = L + MA_K_OFF + (32 * mt + c) * MA_P + 16 * h2; const LAS unsigned char* bp = L + MA_V_OFF + (32 * nt + c) * MA_P + 16 * h2;
    const pg8::u32x4 ones_u = {0x3f803f80u, 0x3f803f80u, 0x3f803f80u, 0x3f803f80u}; const bf16x8 ones = __builtin_bit_cast(bf16x8, ones_u);
#pragma unroll 4
    for (int ks = 0; ks < 16; ++ks) { const bf16x8 a = *(const LAS bf16x8*)(ap + 32 * ks), b = *(const LAS bf16x8*)(bp + 32 * ks);
        acc = MFMA32(a, b, acc); if (nt == 0) accn = MFMA32(a, ones, accn); }
    float* out = cloc + (size_t)(sc * 4 + hh) * CLOC_STRIDE;
#pragma unroll
    for (int i = 0; i < 16; ++i) out[(32 * mt + crow(i, h2)) * 128 + 32 * nt + c] = acc[i];
    if (nt == 0 && c == 0) {
#pragma unroll
        for (int i = 0; i < 16; ++i) out[8192 + 32 * mt + crow(i, h2)] = accn[i]; }
    __syncthreads();
}
constexpr int MC_KP = 144, MC_VP = 520, MC_K_OFF = 0, MC_V_OFF = 256 * MC_KP, MC_C_OFF = MC_V_OFF + 128 * MC_VP, MC_AL = MC_C_OFF + 128 * MC_KP, MC_ML = MC_AL + 1024, MC_BL = MC_ML + 1024,
              MC_NST = MC_BL + 1024, MC_COEF = MC_NST + 256, MC_TMP = MC_COEF + 256, MC_END = MC_TMP + 64;
static_assert(MC_END <= RING_BYTES && MC_AL % 16 == 0, "mLSTM phase C LDS");
__device__ __forceinline__ void mlstm_c_unit(LAS unsigned char* L, const bf16* __restrict__ PB, const float* __restrict__ ibp, const float* __restrict__ fbp, const float* __restrict__ cloc, const float* __restrict__ msc, bf16* __restrict__ YB, int sc, int hh, int tid, int lane, int wave) {
    const bf16* base = PB + (size_t)sc * SC * ODD_PAD;
    LAS float* alS = (LAS float*)(L + MC_AL); LAS float* MlS = (LAS float*)(L + MC_ML); LAS float* blS = (LAS float*)(L + MC_BL); LAS float* nst = (LAS float*)(L + MC_NST);
    LAS float* coefS = (LAS float*)(L + MC_COEF); LAS float* tmp = (LAS float*)(L + MC_TMP);
    if (wave == 0) { const int j = lane; const bool in = j < sc; float b = 0.f, am = 0.f;
        if (in) { b = msc[(j * 4 + hh) * 2]; am = msc[(j * 4 + hh) * 2 + 1]; }
        float Bs = in ? b : 0.f, Cs = in ? b + am : -INFINITY;
#pragma unroll
        for (int d = 1; d < 64; d <<= 1) { const float Bu = __shfl_up(Bs, d), Cu = __shfl_up(Cs, d); if (lane >= d) { Cs = fmaxf(Cu + Bs, Cs); Bs = Bu + Bs; } }
        const float Btot = __shfl(Bs, 63), Ctot = __shfl(Cs, 63), ms = fmaxf(Btot, Ctot);
        coefS[lane] = in ? __expf(Btot - Bs + b + am - ms) : 0.f;
        if (lane == 0) tmp[8] = ms; }
    float lf = 0.f, ipre = 0.f;
    if (tid < 256) { const bf16* r = base + (size_t)tid * ODD_PAD; lf = logsig_f(bf2f(r[O_DF + hh]) + fbp[hh]); ipre = bf2f(r[O_DI + hh]) + ibp[hh]; }
    const float bl = scan256_add(lf, tmp, lane, wave), al = tid < 256 ? ipre - bl : -INFINITY;
    const float ms_in = tmp[8];
    const float cm = scan256_max(al, tmp, lane, wave);
    if (tid < 256) { alS[tid] = al; blS[tid] = bl; MlS[tid] = fmaxf(ms_in, cm); }
    { const int dv = tid & 127, g4 = tid >> 7; float a[16], na = 0.f;
#pragma unroll
        for (int e = 0; e < 16; ++e) a[e] = 0.f;
        for (int j = sc - 1; j >= 0; --j) { const float cf = coefS[j]; if (cf == 0.f) continue;
            const float* src = cloc + (size_t)(j * 4 + hh) * CLOC_STRIDE;
#pragma unroll
            for (int e = 0; e < 16; ++e) a[e] += cf * src[(16 * g4 + e) * 128 + dv];
            if (tid < 64) na += cf * src[8192 + tid]; }
#pragma unroll
        for (int e2 = 0; e2 < 8; ++e2) *(LAS unsigned*)(L + MC_C_OFF + dv * MC_KP + (16 * g4 + 2 * e2) * 2) = pg8::cvt_pk_bf16(a[2 * e2], a[2 * e2 + 1]);
        if (tid < 64) nst[tid] = na; }
#pragma unroll
    for (int i = 0; i < 4; ++i) { const int cidx = tid + 512 * i, row = cidx >> 3, ch = cidx & 7; const uint4 v = *(const uint4*)(base + (size_t)row * ODD_PAD + O_DK + hh * 64 + ch * 8);
        *(LAS pg8::u32x4*)(L + MC_K_OFF + row * MC_KP + ch * 16) = (pg8::u32x4){v.x, v.y, v.z, v.w}; }
    stage_transposed<4>(L + MC_V_OFF, MC_VP, base + O_DV + hh * 128, tid);
    __syncthreads();
    const int c = lane & 31, h2 = lane >> 5, t = 32 * wave + c; const bf16* row = base + (size_t)t * ODD_PAD;
    bf16x8 qf[4];
#pragma unroll
    for (int ks = 0; ks < 4; ++ks) qf[ks] = *(const bf16x8*)(row + O_DQ + hh * 64 + 16 * ks + 8 * h2);
    f32x16 o[4];
#pragma unroll
    for (int dt = 0; dt < 4; ++dt) {
#pragma unroll
        for (int i = 0; i < 16; ++i) o[dt][i] = 0.f;
        const LAS unsigned char* ap = L + MC_C_OFF + (32 * dt + c) * MC_KP + 16 * h2;
#pragma unroll
        for (int ks = 0; ks < 4; ++ks) o[dt] = MFMA32(*(const LAS bf16x8*)(ap + 32 * ks), qf[ks], o[dt]); }
    const float Ml = MlS[t], ex = __expf(ms_in - Ml) * 0.125f;
#pragma unroll
    for (int dt = 0; dt < 4; ++dt) o[dt] = o[dt] * ex;
    float dq = 0.f;
#pragma unroll
    for (int ks = 0; ks < 4; ++ks)
#pragma unroll
        for (int e = 0; e < 8; ++e) dq += bf2f((bf16)qf[ks][e]) * nst[16 * ks + 8 * h2 + e];
    dq += __shfl_xor(dq, 32);
    float psum = 0.f;
    for (int kt = 0; kt <= wave; ++kt) {
        f32x16 acc;
#pragma unroll
        for (int i = 0; i < 16; ++i) acc[i] = 0.f;
        const LAS unsigned char* kp = L + MC_K_OFF + (32 * kt + c) * MC_KP + 16 * h2;
#pragma unroll
        for (int ks = 0; ks < 4; ++ks) acc = MFMA32(*(const LAS bf16x8*)(kp + 32 * ks), qf[ks], acc);
        const bool diag = kt == wave;
#pragma unroll
        for (int iq = 0; iq < 4; ++iq) { const pg8::f32x4 a4 = *(const LAS pg8::f32x4*)(alS + 32 * kt + 8 * iq + 4 * h2);
#pragma unroll
            for (int e = 0; e < 4; ++e) { const int srel = 8 * iq + 4 * h2 + e; const float wgt = __expf(a4[e] - Ml) * 0.125f;
                const float p = (!diag || srel <= c) ? acc[4 * iq + e] * wgt : 0.f; acc[4 * iq + e] = p; psum += p; } }
#pragma unroll
        for (int s = 0; s < 2; ++s) { const bf16x8 pb = pack8_acc(acc, s); const int kb = 32 * kt + 16 * s + 4 * h2;
#pragma unroll
            for (int dt = 0; dt < 4; ++dt) { const LAS unsigned char* vp = L + MC_V_OFF + (32 * dt + c) * MC_VP + kb * 2;
                const u32x2 lo = *(const LAS u32x2*)vp, hi = *(const LAS u32x2*)(vp + 16); const pg8::u32x4 av = {lo.x, lo.y, hi.x, hi.y};
                o[dt] = MFMA32(__builtin_bit_cast(bf16x8, av), pb, o[dt]); } }
        __builtin_amdgcn_sched_barrier(0);
    }
    psum += __shfl_xor(psum, 32);
    const float den = ex * dq + psum, inv = 1.f / fmaxf(fabsf(den), __expf(-(blS[t] + Ml)));
    const bf16* orow = row + O_DO + hh * 128; const bf16* grow = row + O_GD + hh * 128; bf16* yrow = YB + (size_t)(sc * SC + t) * D + 512 + hh * 128;
#pragma unroll
    for (int dt = 0; dt < 4; ++dt)
#pragma unroll
        for (int iq = 0; iq < 4; ++iq) { const int d = 32 * dt + 8 * iq + 4 * h2; const uint2 ov = *(const uint2*)(orow + d), gv = *(const uint2*)(grow + d);
            const float o0 = __uint_as_float(ov.x << 16), o1 = __uint_as_float(ov.x & 0xffff0000u), o2 = __uint_as_float(ov.y << 16), o3 = __uint_as_float(ov.y & 0xffff0000u);
            const float g0 = __uint_as_float(gv.x << 16), g1 = __uint_as_float(gv.x & 0xffff0000u), g2 = __uint_as_float(gv.y << 16), g3 = __uint_as_float(gv.y & 0xffff0000u);
            uint2 w; w.x = pg8::cvt_pk_bf16(o[dt][4 * iq] * inv * sigmoid_f(o0) * silu_f(g0), o[dt][4 * iq + 1] * inv * sigmoid_f(o1) * silu_f(g1));
            w.y = pg8::cvt_pk_bf16(o[dt][4 * iq + 2] * inv * sigmoid_f(o2) * silu_f(g2), o[dt][4 * iq + 3] * inv * sigmoid_f(o3) * silu_f(g3));
            *(uint2*)(yrow + d) = w; }
    __syncthreads();
}

struct Args { const float* in[14]; float* out; unsigned char* ws; int ph_lo, ph_hi, li, pad; };
__global__ void __launch_bounds__(NWAVES * 64, 2) mk_fwd(Args args) {
    extern __shared__ __attribute__((aligned(16))) unsigned char lds[];
    LAS unsigned char* const L = (LAS unsigned char*)lds;
    volatile LAS unsigned* const MISC = (volatile LAS unsigned*)(L + MISC_OFF);
    const int tid = threadIdx.x, lane = tid & 63, wave = __builtin_amdgcn_readfirstlane(tid >> 6);
    const int G = gridDim.x, bx = blockIdx.x, vcu = (G % 8 == 0) ? (bx % 8) * (G / 8) + bx / 8 : bx;
    unsigned char* ws = args.ws; gu32* ctl = (gu32*)(ws + WS_CTL);
    const float* x = args.in[0]; float* out = args.out;
    float* ss0 = (float*)(ws + WS_SS0); float* ss1 = (float*)(ws + WS_CTL + 65536); float* ss2 = (float*)(ws + WS_CTL + 131072);
    bf16 *W1 = (bf16*)(ws + WS_W1), *W2 = (bf16*)(ws + WS_W2), *W3 = (bf16*)(ws + WS_W3), *W4 = (bf16*)(ws + WS_W4), *XB = (bf16*)(ws + WS_XB), *YB = (bf16*)(ws + WS_YB), *PB = (bf16*)(ws + WS_PB);
    for (int u = tid; u < (LDS_BYTES - LDSCTL_OFF) / 4; u += NWAVES * 64) ((LAS unsigned*)(L + LDSCTL_OFF))[u] = 0u;
    __syncthreads();
    const int lo = args.ph_lo, hi = args.ph_hi;
    XcdBarrier bar; bar.bar = (unsigned*)(ctl + CW_BAR) + args.li * XCD_BAR_WORDS; bar.x = 0; bar.st = nullptr;
    if (hi - lo > 1) bar = xcd_barrier_post((unsigned*)(ctl + CW_BAR) + args.li * XCD_BAR_WORDS, MISC + 8);
#define IN(k) (lo <= (k) && (k) < hi)
#define SEAM(k) do { if (IN(k) && IN((k) + 1)) xcd_barrier(bar); } while (0)
    const int gw = vcu * NWAVES + wave, NGW = G * NWAVES;

    if (IN(0)) REPS(0) {
        WPrep P{args.in[1], args.in[2], args.in[4], args.in[5], args.in[6], args.in[7], args.in[8], args.in[12], W1, W2, W3, W4};
        for (int it = bx; it < 256; it += G) wprep_pool_item(P, it >> 4, it & 15, (float*)(lds + RING_OFF), tid, lane, wave);
        float* scr = (float*)(lds + RING_OFF + wave * 16384);
        for (int it = gw; it < WI_ALL; it += NGW) {
            int r = it, mat, nblk;
            if (r < WI_0) { mat = 0; nblk = 96; } else if ((r -= WI_0) < WI_1) { mat = 1; nblk = 32; } else if ((r -= WI_1) < WI_2) { mat = 2; nblk = 112; } else { r -= WI_2; mat = 3; nblk = 32; }
            const int kb = r / nblk, nb = r % nblk;
            if (mat == 0 && nb >= 64 && nb < 80) continue;
            wprep_item(P, mat, kb, nb, scr, lane);
        }
        for (int row = gw; row < S; row += NGW) prep_x_row(x, XB, ss0, row, lane);
    }
    SEAM(0);
    if (IN(1)) REPS(1) {
        pg8::Gemm g{XB, W1, S, EVEN_IN, D}; pg8::StaticOrder So; So.init(S, EVEN_IN, G, bx);
        pg8::EpiScaleBf16 E{PB, EVEN_IN, ss0};
        pg8::gemm_phase<pg8::EpiScaleBf16, pg8::StaticOrder, PG8_ALIGN, PG8_SP2>(L + RING_OFF, g, So, E);
    }
    SEAM(1);
    if (IN(2)) REPS(2) { for (int u = gw; u < (S / EM_RUN) * 2; u += NGW) even_mix_unit(PB, args.in[3], YB, u, lane); }
    SEAM(2);
    float* ssd = (float*)(ws + WS_CTL + 196608);
    if (IN(3)) REPS(3) {
        pg8::Gemm g{YB, W2, S, D, D}; pg8::StaticOrder So; So.init(S, D, G, bx);
        pg8::EpiResid E{XB, nullptr, XB, rep ? ssd : ss1};
        pg8::gemm_phase<pg8::EpiResid, pg8::StaticOrder, false, PG8_SP2>(L + RING_OFF, g, So, E);
    }
    SEAM(3);
    if (IN(4)) REPS(4) {
        pg8::Gemm g{XB, W3, S, ODD_PAD, D}; pg8::StaticOrder So; So.init(S, ODD_PAD, G, bx);
        pg8::EpiScaleBf16 E{PB, ODD_PAD, ss1};
        pg8::gemm_phase<pg8::EpiScaleBf16, pg8::StaticOrder, PG8_ALIGN, PG8_SP2>(L + RING_OFF, g, So, E);
    }
    SEAM(4);
    float* cloc = (float*)(ws + WS_CLOC); float* msc = (float*)(ws + WS_MSC);
    if (IN(5)) REPS(5) { for (int u = bx; u < 256; u += G) { attn_unit(L + RING_OFF, PB, args.in[11], YB, u >> 1, u & 1, tid, lane, wave);
                                                     mlstm_a_unit(L + RING_OFF, PB, args.in[9], args.in[10], cloc, msc, u >> 2, u & 3, tid, lane, wave); } }
    SEAM(5);
    if (IN(6)) REPS(6) { for (int u = bx; u < 256; u += G) mlstm_c_unit(L + RING_OFF, PB, args.in[9], args.in[10], cloc, msc, YB, u >> 2, u & 3, tid, lane, wave); }
    SEAM(6);
    if (IN(7)) REPS(7) {
        pg8::Gemm g{YB, W4, S, D, D}; pg8::StaticOrder So; So.init(S, D, G, bx);
        pg8::EpiResid E{XB, rep ? (float*)PB : out, nullptr, rep ? ssd : ss2};
        pg8::gemm_phase<pg8::EpiResid, pg8::StaticOrder, false, PG8_SP2>(L + RING_OFF, g, So, E);
    }
    SEAM(7);
    if (IN(8)) REPS(8) { const bool dummy = (DUP == 8 && rep == 0); for (int row = gw; row < S; row += NGW) final_row(out, dummy ? (float*)PB : out, ss2, args.in[13], row, lane); }
#undef IN
#undef SEAM
}
extern "C" void kernel_launch(void* const* d_in, const int* in_sizes, int n_in, void* d_out, int out_size, void* d_ws, size_t ws_size, hipStream_t stream) {
    static int grid = 0;
    if (grid == 0) {
        if (n_in != 14 || in_sizes[0] != S * D || out_size != S * D || ws_size < WS_END) { fprintf(stderr, "kernel_launch: unexpected shapes (n_in %d out %d ws %zu)\n", n_in, out_size, ws_size); grid = -1; return; }
        int dev = 0, cus = 0;
        if (hipGetDevice(&dev) != hipSuccess || hipDeviceGetAttribute(&cus, hipDeviceAttributeMultiprocessorCount, dev) != hipSuccess) { grid = -1; return; }
        if (hipFuncSetAttribute((const void*)mk_fwd, hipFuncAttributeMaxDynamicSharedMemorySize, LDS_BYTES) != hipSuccess) { fprintf(stderr, "kernel_launch: hipFuncSetAttribute failed\n"); grid = -1; return; }
        grid = cus;
    }
    if (grid < 0) return;
    unsigned char* ws = (unsigned char*)d_ws;
    (void)hipMemsetAsync(ws + WS_CTL, 0, CTL_BYTES, stream);
    Args a{};
    for (int i = 0; i < 14; ++i) a.in[i] = (const float*)d_in[i];
    a.out = (float*)d_out; a.ws = ws;
    int li = 0;
#define MK(lo_, hi_) do { a.ph_lo = (lo_); a.ph_hi = (hi_); a.li = li++; hipLaunchKernelGGL(mk_fwd, dim3(grid), dim3(NWAVES * 64), LDS_BYTES, stream, a); } while (0)
    MK(0, N_PHASES);
#undef MK
}
```
